# Optimizing an MI355X kernel written in HIP

```python
import math
import jax
import jax.numpy as jnp
from jax import lax
import numpy as np

D_MODEL = 1024
BATCH = 2
SEQ = 8192
DEPTH = 4

N_META = 16
S5_WIDTH = 512
S5_GROUP = 16
S5_GROUPS = S5_WIDTH // S5_GROUP
S5_STATE = 64
DT_MIN = 1e-3
DT_MAX = 1e-1
LRU_WIDTH = 512
LRU_HEADS = 8
LRU_HEAD_DIM = LRU_WIDTH // LRU_HEADS
CONV_WIDTH = 4
LRU_C = 8.0
N_BRANCH = 2
D_IN = S5_WIDTH + 2 * LRU_WIDTH + N_BRANCH * D_MODEL
DENSE_FF = 3 * D_MODEL
N_EXPERTS = 8
TOP_K = 2
EXPERT_FF = 3 * D_MODEL // 2
MOE_BLOCK = 256
N_DENSE = (DEPTH + 1) // 2
N_MOE = DEPTH // 2
EPS = 1e-6

kernel_name = "hybrid_s5_rglru_gated_moe_trunk"


def rmsnorm(x, g):
    x32 = x.astype(jnp.float32)
    y = x32 * lax.rsqrt(jnp.mean(x32 * x32, axis=-1, keepdims=True) + EPS)
    return (y * g.astype(jnp.float32)).astype(x.dtype)


def _complex_linear_combine(left, right):
    a1r, a1i, b1r, b1i = left
    a2r, a2i, b2r, b2i = right
    return (a2r * a1r - a2i * a1i,
            a2r * a1i + a2i * a1r,
            a2r * b1r - a2i * b1i + b2r,
            a2r * b1i + a2i * b1r + b2i)


def _real_linear_combine(left, right):
    a1, b1 = left
    a2, b2 = right
    return (a1 * a2, a2 * b1 + b2)


def s5_branch(u, lam_re, lam_im, log_dt, b_re, b_im, c_re, c_im, d_skip, w_glu, b_glu):
    f32 = jnp.float32
    bsz, t, _ = u.shape
    u32 = u.astype(f32)
    ug = u32.reshape(bsz, t, S5_GROUPS, S5_GROUP)
    lr = lam_re.astype(f32)
    li = lam_im.astype(f32)
    dt = jnp.exp(log_dt.astype(f32))[:, None]
    mag = jnp.exp(lr * dt)
    ab_re = mag * jnp.cos(li * dt)
    ab_im = mag * jnp.sin(li * dt)
    den = lr * lr + li * li
    num_re = ab_re - 1.0
    coef_re = (num_re * lr + ab_im * li) / den
    coef_im = (ab_im * lr - num_re * li) / den
    br = b_re.astype(f32)
    bi = b_im.astype(f32)
    bb_re = coef_re[..., None] * br - coef_im[..., None] * bi
    bb_im = coef_re[..., None] * bi + coef_im[..., None] * br
    bu_re = jnp.einsum('btgh,gph->btgp', ug, bb_re)
    bu_im = jnp.einsum('btgh,gph->btgp', ug, bb_im)
    a_re = jnp.broadcast_to(ab_re, bu_re.shape)
    a_im = jnp.broadcast_to(ab_im, bu_re.shape)
    _, _, s_re, s_im = lax.associative_scan(
        _complex_linear_combine, (a_re, a_im, bu_re, bu_im), axis=1)
    y = (jnp.einsum('btgp,ghp->btgh', s_re, c_re.astype(f32))
         - jnp.einsum('btgp,ghp->btgh', s_im, c_im.astype(f32)))
    y = y.reshape(bsz, t, S5_WIDTH) + d_skip.astype(f32) * u32
    y = jax.nn.gelu(y).astype(u.dtype)
    return y * jax.nn.sigmoid(y @ w_glu + b_glu)


def rglru_branch(xb, gate_in, conv_w, conv_b, w_r, b_r, w_i, b_i, lam):
    f32 = jnp.float32
    bsz, t, c = xb.shape
    xc = lax.conv_general_dilated(
        xb, conv_w[:, None, :], window_strides=(1,), padding=[(CONV_WIDTH - 1, 0)],
        dimension_numbers=('NWC', 'WIO', 'NWC'), feature_group_count=c) + conv_b
    x32 = xc.astype(f32)
    xh = x32.reshape(bsz, t, LRU_HEADS, LRU_HEAD_DIM)
    r = jax.nn.sigmoid(jnp.einsum('btnh,nhk->btnk', xh, w_r.astype(f32)).reshape(bsz, t, c)
                       + b_r.astype(f32))
    i = jax.nn.sigmoid(jnp.einsum('btnh,nhk->btnk', xh, w_i.astype(f32)).reshape(bsz, t, c)
                       + b_i.astype(f32))
    log_a = -LRU_C * r * jax.nn.softplus(-lam.astype(f32))
    a = jnp.exp(log_a)
    mult = jnp.sqrt(-jnp.expm1(2.0 * log_a))
    b = mult * (i * x32)
    _, h = lax.associative_scan(_real_linear_combine, (a, b), axis=1)
    return (h * jax.nn.gelu(gate_in.astype(f32))).astype(xb.dtype)


def swiglu(h, w_gate, w_up, w_down):
    return (jax.nn.silu(h @ w_gate) * (h @ w_up)) @ w_down


def moe_swiglu(x2d, router_w, router_b, w_gate, w_up, w_down):
    n, d = x2d.shape
    logits = (x2d @ router_w).astype(jnp.float32) + router_b.astype(jnp.float32)
    top_val, top_idx = lax.top_k(logits, TOP_K)
    gates = jax.nn.softmax(top_val, axis=-1)
    nk = n * TOP_K
    flat_e = top_idx.reshape(nk)
    flat_tok = jnp.arange(nk, dtype=jnp.int32) // TOP_K
    flat_g = gates.reshape(nk)
    order = jnp.argsort(flat_e, stable=True)
    sorted_e = flat_e[order]
    counts = jnp.bincount(flat_e, length=N_EXPERTS)
    padded = ((counts + MOE_BLOCK - 1) // MOE_BLOCK) * MOE_BLOCK
    cum_pad = jnp.cumsum(padded)
    pad_start = cum_pad - padded
    start = jnp.cumsum(counts) - counts
    rank = jnp.arange(nk, dtype=jnp.int32) - start[sorted_e]
    dest = pad_start[sorted_e] + rank
    n_blocks = -(-nk // MOE_BLOCK) + N_EXPERTS
    n_slots = n_blocks * MOE_BLOCK
    slot_tok = jnp.full((n_slots,), n, dtype=jnp.int32).at[dest].set(flat_tok[order])
    slot_gate = jnp.zeros((n_slots,), jnp.float32).at[dest].set(flat_g[order])
    block_start = jnp.arange(n_blocks, dtype=jnp.int32) * MOE_BLOCK
    block_expert = jnp.minimum(jnp.searchsorted(cum_pad, block_start, side='right'),
                               N_EXPERTS - 1).astype(jnp.int32)
    x_pad = jnp.concatenate([x2d, jnp.zeros((1, d), x2d.dtype)], axis=0)
    xs = x_pad[slot_tok].reshape(n_blocks, MOE_BLOCK, d)

    def expert_block(args):
        xb, e = args
        return swiglu(xb, w_gate[e], w_up[e], w_down[e])

    ys = lax.map(expert_block, (xs, block_expert)).reshape(n_slots, d)
    ys = ys * slot_gate[:, None].astype(ys.dtype)
    out = jnp.zeros((n + 1, d), ys.dtype).at[slot_tok].add(ys)
    return out[:n]


def setup_inputs(seed: int = 0) -> dict:
    key = jax.random.key(seed)
    ks = iter(jax.random.split(key, 48))
    f32 = jnp.float32

    def nrm(shape, scale):
        return jax.random.normal(next(ks), shape, f32) * scale

    x = nrm((BATCH, SEQ, D_MODEL), 1.0)
    meta_tokens = nrm((N_META, D_MODEL), 1.0)
    mix_norm = 1.0 + nrm((DEPTH, D_MODEL), 0.01)
    w_in = nrm((DEPTH, D_MODEL, D_IN), D_MODEL ** -0.5)
    merge_bias = nrm((DEPTH, N_BRANCH * D_MODEL), 0.01)
    n_idx = jnp.arange(S5_STATE, dtype=f32)
    s5_lambda_re = -0.5 + nrm((DEPTH, S5_GROUPS, S5_STATE), 0.01)
    s5_lambda_im = math.pi * n_idx + nrm((DEPTH, S5_GROUPS, S5_STATE), 0.01)
    s5_log_dt = jax.random.uniform(next(ks), (DEPTH, S5_GROUPS), f32,
                                   math.log(DT_MIN), math.log(DT_MAX))
    s5_b_re = nrm((DEPTH, S5_GROUPS, S5_STATE, S5_GROUP), (2 * S5_GROUP) ** -0.5)
    s5_b_im = nrm((DEPTH, S5_GROUPS, S5_STATE, S5_GROUP), (2 * S5_GROUP) ** -0.5)
    s5_c_re = nrm((DEPTH, S5_GROUPS, S5_GROUP, S5_STATE), (2 * S5_STATE) ** -0.5)
    s5_c_im = nrm((DEPTH, S5_GROUPS, S5_GROUP, S5_STATE), (2 * S5_STATE) ** -0.5)
    s5_d = nrm((DEPTH, S5_WIDTH), 1.0)
    s5_w_glu = nrm((DEPTH, S5_WIDTH, S5_WIDTH), S5_WIDTH ** -0.5)
    s5_b_glu = nrm((DEPTH, S5_WIDTH), 0.01)
    s5_w_proj = nrm((DEPTH, S5_WIDTH, D_MODEL), S5_WIDTH ** -0.5)
    lru_conv_w = nrm((DEPTH, CONV_WIDTH, LRU_WIDTH), CONV_WIDTH ** -0.5)
    lru_conv_b = nrm((DEPTH, LRU_WIDTH), 0.01)
    lru_w_rgate = nrm((DEPTH, LRU_HEADS, LRU_HEAD_DIM, LRU_HEAD_DIM), LRU_HEAD_DIM ** -0.5)
    lru_b_rgate = nrm((DEPTH, LRU_WIDTH), 0.01)
    lru_w_igate = nrm((DEPTH, LRU_HEADS, LRU_HEAD_DIM, LRU_HEAD_DIM), LRU_HEAD_DIM ** -0.5)
    lru_b_igate = nrm((DEPTH, LRU_WIDTH), 0.01)
    a_c = jax.random.uniform(next(ks), (DEPTH, LRU_WIDTH), f32, 0.9, 0.999)
    s = a_c ** (1.0 / LRU_C)
    lru_lambda = jnp.log(s) - jnp.log1p(-s)
    lru_w_proj = nrm((DEPTH, LRU_WIDTH, D_MODEL), LRU_WIDTH ** -0.5)
    w_out = nrm((DEPTH, D_MODEL, D_MODEL), D_MODEL ** -0.5)
    ffn_norm = 1.0 + nrm((DEPTH, D_MODEL), 0.01)
    dense_w_gate = nrm((N_DENSE, D_MODEL, DENSE_FF), D_MODEL ** -0.5)
    dense_w_up = nrm((N_DENSE, D_MODEL, DENSE_FF), D_MODEL ** -0.5)
    dense_w_down = nrm((N_DENSE, DENSE_FF, D_MODEL), DENSE_FF ** -0.5)
    router_w = nrm((N_MOE, D_MODEL, N_EXPERTS), D_MODEL ** -0.5)
    router_b = nrm((N_MOE, N_EXPERTS), 0.01)
    moe_w_gate = nrm((N_MOE, N_EXPERTS, D_MODEL, EXPERT_FF), D_MODEL ** -0.5)
    moe_w_up = nrm((N_MOE, N_EXPERTS, D_MODEL, EXPERT_FF), D_MODEL ** -0.5)
    moe_w_down = nrm((N_MOE, N_EXPERTS, EXPERT_FF, D_MODEL), EXPERT_FF ** -0.5)
    final_norm = 1.0 + nrm((D_MODEL,), 0.01)
    return {
        "x": x, "meta_tokens": meta_tokens, "mix_norm": mix_norm, "w_in": w_in,
        "merge_bias": merge_bias, "s5_lambda_re": s5_lambda_re, "s5_lambda_im": s5_lambda_im,
        "s5_log_dt": s5_log_dt, "s5_b_re": s5_b_re, "s5_b_im": s5_b_im,
        "s5_c_re": s5_c_re, "s5_c_im": s5_c_im, "s5_d": s5_d, "s5_w_glu": s5_w_glu,
        "s5_b_glu": s5_b_glu, "s5_w_proj": s5_w_proj, "lru_conv_w": lru_conv_w,
        "lru_conv_b": lru_conv_b, "lru_w_rgate": lru_w_rgate, "lru_b_rgate": lru_b_rgate,
        "lru_w_igate": lru_w_igate, "lru_b_igate": lru_b_igate, "lru_lambda": lru_lambda,
        "lru_w_proj": lru_w_proj, "w_out": w_out, "ffn_norm": ffn_norm,
        "dense_w_gate": dense_w_gate, "dense_w_up": dense_w_up, "dense_w_down": dense_w_down,
        "router_w": router_w, "router_b": router_b, "moe_w_gate": moe_w_gate,
        "moe_w_up": moe_w_up, "moe_w_down": moe_w_down, "final_norm": final_norm,
    }


def reference(x, meta_tokens, mix_norm, w_in, merge_bias, s5_lambda_re, s5_lambda_im,
              s5_log_dt, s5_b_re, s5_b_im, s5_c_re, s5_c_im, s5_d, s5_w_glu, s5_b_glu,
              s5_w_proj, lru_conv_w, lru_conv_b, lru_w_rgate, lru_b_rgate, lru_w_igate,
              lru_b_igate, lru_lambda, lru_w_proj, w_out, ffn_norm, dense_w_gate,
              dense_w_up, dense_w_down, router_w, router_b, moe_w_gate, moe_w_up,
              moe_w_down, final_norm):
    bsz = x.shape[0]
    meta = jnp.broadcast_to(meta_tokens[None].astype(x.dtype), (bsz, N_META, D_MODEL))
    hs = jnp.concatenate([meta, x], axis=1)
    t = hs.shape[1]
    o_x = S5_WIDTH
    o_g = S5_WIDTH + LRU_WIDTH
    o_m = S5_WIDTH + 2 * LRU_WIDTH
    for layer in range(DEPTH):
        hn = rmsnorm(hs, mix_norm[layer])
        z = hn @ w_in[layer]
        u_s5 = z[..., :o_x]
        x_lru = z[..., o_x:o_g]
        g_lru = z[..., o_g:o_m]
        gates = jax.nn.sigmoid(z[..., o_m:] + merge_bias[layer]).reshape(
            bsz, t, N_BRANCH, D_MODEL)
        y_a = s5_branch(u_s5, s5_lambda_re[layer], s5_lambda_im[layer], s5_log_dt[layer],
                        s5_b_re[layer], s5_b_im[layer], s5_c_re[layer], s5_c_im[layer],
                        s5_d[layer], s5_w_glu[layer], s5_b_glu[layer]) @ s5_w_proj[layer]
        y_b = rglru_branch(x_lru, g_lru, lru_conv_w[layer], lru_conv_b[layer],
                           lru_w_rgate[layer], lru_b_rgate[layer], lru_w_igate[layer],
                           lru_b_igate[layer], lru_lambda[layer]) @ lru_w_proj[layer]
        y = gates[:, :, 0, :] * y_a + gates[:, :, 1, :] * y_b
        hs = hs + y @ w_out[layer]
        hn = rmsnorm(hs, ffn_norm[layer])
        j = layer // 2
        if layer % 2 == 0:
            hs = hs + swiglu(hn, dense_w_gate[j], dense_w_up[j], dense_w_down[j])
        else:
            f = moe_swiglu(hn.reshape(bsz * t, D_MODEL), router_w[j], router_b[j],
                           moe_w_gate[j], moe_w_up[j], moe_w_down[j])
            hs = hs + f.reshape(bsz, t, D_MODEL)
    return rmsnorm(hs[:, N_META:], final_norm)
```

```cpp
#include <hip/hip_runtime.h>
#include <cstdio>
#include <cstdint>
#include <cstring>

#ifndef REPMASK
#define REPMASK 0
#endif
#define REPS(n) (((REPMASK) >> (n)) & 1)
#ifndef ONE_LAUNCH
#define ONE_LAUNCH 1
#endif

typedef unsigned short bf16_t;
typedef short bf16x8 __attribute__((ext_vector_type(8)));
typedef float f32x4 __attribute__((ext_vector_type(4)));
typedef float f32x2 __attribute__((ext_vector_type(2)));
typedef unsigned u32x2 __attribute__((ext_vector_type(2)));
typedef unsigned u32x4 __attribute__((ext_vector_type(4)));
#define LAS __attribute__((address_space(3)))

constexpr int D = 1024, NTOK = 16384, SEQ = 8192, NMETA = 16, NV = NTOK + NMETA, MP = 16640;
constexpr int DIN = 3584, S5W = 512, LRUW = 512, NG = 32, NP = 64, NH = 16;
constexpr int DFF = 3072, EFF = 1536, NEXP = 8, DEPTH = 4;
constexpr int NPANEL = 65;
constexpr int MAXSLOT = 137 * 256;
constexpr int NCHUNK = 257;
constexpr float EPS = 1e-6f;
constexpr int NTHREADS = 512;
constexpr int LDS_MISC_OFF = 147456 - 64;

constexpr size_t al256(size_t x) { return (x + 255) & ~(size_t)255; }
constexpr size_t WS_CTL = 0;
constexpr int WMM = 3;
constexpr size_t WS_LFLAG = 319488;
constexpr size_t WS_SFLAG = WS_LFLAG + (size_t)NPANEL * 8 * 64;
constexpr size_t WS_PCNT = 491520;
constexpr size_t WS_CNTX = 491520 + (size_t)DEPTH * 2 * 65 * 64;
constexpr size_t CTL_BYTES = WS_CNTX + 8448;
constexpr bool FUSE_POST = false;
constexpr int WOUT_F8_FROM = 0;
constexpr float YSC = 16.0f;
constexpr bool SKIP_HS0 = true;
constexpr bool WIN_SPLIT = (WMM == 3);
constexpr int WIN_NB = 3072;
constexpr bool FUSE_RD = true;
static_assert(WS_SFLAG + (size_t)NPANEL * 32 * 64 <= WS_PCNT, "control region");
constexpr size_t WS_CMAX = 16384;
constexpr int CMAX_MOE = 2 * 2 * DFF;
constexpr int CMAX_WIN = CMAX_MOE + 2 * NEXP * 2 * EFF;
constexpr size_t WS_WIN = WS_CTL + CTL_BYTES;
constexpr size_t SZ_WIN = (size_t)DIN * D * (WMM == 2 ? 2 : 1);
constexpr size_t WS_WGLU = WS_WIN + 4 * SZ_WIN;
constexpr size_t SZ_WGLU = (size_t)512 * 512 * 2;
constexpr size_t WS_WPROJ = WS_WGLU + 4 * SZ_WGLU;
constexpr size_t SZ_WPROJ = (size_t)D * D * 2;
constexpr size_t WS_WOUT = WS_WPROJ + 4 * SZ_WPROJ;
constexpr size_t WS_DGU = WS_WOUT + 4 * SZ_WPROJ;
constexpr float FSC = 1.0f / 32.0f;
constexpr int UMM = 3;
constexpr int UESZ = (UMM == 2) ? 2 : 1;
constexpr bool NEED_HSB = (WMM == 2) || (UMM == 2);

constexpr int DESZ_D2 = 1;
constexpr int DESZ_D = 2;
constexpr int DESZ_M = 1;
constexpr int DESZ_MAX = 2;
constexpr size_t SZ_DGU = (size_t)2 * DFF * D * UESZ;
constexpr size_t WS_DDN = WS_DGU + 2 * SZ_DGU;
constexpr size_t SZ_DDN = (size_t)D * DFF * 2;
constexpr size_t WS_MGU = WS_DDN + 2 * SZ_DDN;
constexpr size_t SZ_MGU = (size_t)2 * EFF * D * UESZ;
constexpr size_t WS_MDN = WS_MGU + 16 * SZ_MGU;
constexpr size_t SZ_MDN = (size_t)D * EFF * DESZ_M;
constexpr size_t WS_S5T = WS_MDN + 16 * SZ_MDN;
constexpr size_t SZ_S5T1 = (size_t)128 * 128 * 2;
constexpr size_t WS_W8 = WS_S5T + (size_t)4 * 32 * 3 * SZ_S5T1;
constexpr size_t WS_W256 = WS_W8 + (size_t)4 * 32 * 64 * 8;
constexpr size_t WS_LRUW = WS_W256 + (size_t)4 * 32 * 64 * 8;
constexpr size_t WS_HS = WS_LRUW + (size_t)4 * 8 * 2 * 4096 * 2;
constexpr size_t WS_HSB = WS_HS + (size_t)MP * D * 4;
constexpr size_t WS_HSB8 = WS_HSB + (size_t)MP * D * 2;
constexpr size_t WS_SA = WS_HSB8 + (UESZ == 1 ? (size_t)MP * D : 0);
constexpr size_t WS_RSP = WS_SA + (size_t)MAXSLOT * 4;
constexpr size_t WS_SPAN = WS_RSP + (size_t)MP * 16 * 4;
constexpr size_t WS_APAN = WS_SPAN + (size_t)NPANEL * 32 * 64 * 8;
constexpr size_t WS_HPAN = WS_APAN + (size_t)NPANEL * 512 * 4;
constexpr size_t WS_TOPE = al256(WS_HPAN + (size_t)NPANEL * 512 * 4);
constexpr size_t WS_TOPG = WS_TOPE + (size_t)MP * 2 * 4;
constexpr size_t WS_RINV = WS_TOPG + (size_t)MP * 2 * 4;
constexpr size_t WS_CNT = WS_RINV + (size_t)MP * 4;
constexpr size_t WS_STOK = al256(WS_CNT + (size_t)NCHUNK * 8 * 4);
constexpr size_t WS_SGATE = WS_STOK + (size_t)MAXSLOT * 4;
constexpr size_t WS_TSLOT = WS_SGATE + (size_t)MAXSLOT * 4;
constexpr size_t WS_TEXP = WS_TSLOT + (size_t)MP * 2 * 4;
constexpr size_t WS_REG = al256(WS_TEXP + 1024);
constexpr size_t T_US5 = WS_REG;
constexpr size_t T_XLRU = T_US5 + (size_t)MP * 512 * 2;
constexpr size_t T_Y = T_US5;
constexpr size_t T_GG = T_XLRU + (size_t)MP * 512 * 2;
constexpr size_t T_GATES = T_GG + (size_t)MP * 512 * 2;
constexpr size_t T_YS5 = T_GATES + (size_t)MP * 2048 * 2;
constexpr size_t T_SOLO = T_YS5 + (size_t)MP * 512 * 2;
constexpr size_t T_END = T_SOLO + (size_t)MP * D * 2;
constexpr size_t F_ACT = WS_REG;
constexpr size_t SZ_ACT = ((size_t)MAXSLOT * EFF > (size_t)MP * DFF ? (size_t)MAXSLOT * EFF : (size_t)MP * DFF) * DESZ_MAX;
constexpr size_t F_YS = F_ACT + SZ_ACT;
constexpr size_t F_XS = F_YS;
constexpr size_t F_END = F_YS + (size_t)MAXSLOT * D * 2;
constexpr size_t WS_END = (T_END > F_END ? T_END : F_END);
static_assert(WS_END <= 544000000ull, "workspace budget");

struct Params {
    const float* in[35];
    float* out;
    unsigned char* ws;
    int s_lo, s_hi;
};

__device__ __forceinline__ f32x4 zero4() { float z = 0.f; asm volatile("" : "+v"(z)); f32x4 r; r[0] = z; r[1] = z; r[2] = z; r[3] = z; return r; }
__device__ __forceinline__ float bf2f(bf16_t b) { return __uint_as_float(((unsigned)b) << 16); }
__device__ __forceinline__ bf16_t f2bf(float f) { unsigned u = __float_as_uint(f); u += 0x7FFFu + ((u >> 16) & 1u); return (bf16_t)(u >> 16); }
__device__ __forceinline__ unsigned pk2(float lo, float hi) { return (unsigned)f2bf(lo) | ((unsigned)f2bf(hi) << 16); }
__device__ __forceinline__ float sat8(float x) { return __builtin_fminf(__builtin_fmaxf(x, -448.0f), 448.0f); }
__device__ __forceinline__ unsigned pk4f8(float a, float b, float c, float d) { int p = __builtin_amdgcn_cvt_pk_fp8_f32(sat8(a), sat8(b), 0, false); p = __builtin_amdgcn_cvt_pk_fp8_f32(sat8(c), sat8(d), p, true); return (unsigned)p; }
__device__ __forceinline__ float sigmoidf_(float x) { return __builtin_amdgcn_rcpf(1.0f + __expf(-x)); }
__device__ __forceinline__ float gelu_tanh(float x) {
    const float u = 0.7978845608028654f * (x + 0.044715f * x * x * x);
    const float t = 1.0f - 2.0f * __builtin_amdgcn_rcpf(1.0f + __expf(2.0f * u));
    return 0.5f * x * (1.0f + t);
}
__device__ __forceinline__ float silu_(float x) { return x * __builtin_amdgcn_rcpf(1.0f + __expf(-x)); }
__device__ __forceinline__ float one_minus_exp(float x) { const float s = -x * (1.0f + x * (0.5f + x * (0.16666667f + x * (0.041666668f + x * 0.0083333338f)))); return (x > -0.25f) ? s : 1.0f - __expf(x); }

__device__ __forceinline__ int lane_id_now() { int l; asm volatile("v_mbcnt_lo_u32_b32 %0, -1, 0\n\tv_mbcnt_hi_u32_b32 %0, -1, %0" : "=v"(l)); return l; }
#define XB_TMO      128
#define XB_XCNT(j)  (256  + 64 * (j))
#define XB_XSUB(j)  (1280 + 64 * (j))
#define XB_XGEN(j)  (2304 + 64 * (j))
#define XB_TOP      3328
#define XB_TOPGEN   3392
#define XCD_BAR_WORDS 3456
#define XB_SPIN_CAP (1u << 18)
__device__ __forceinline__ unsigned xb_ld(unsigned* p)              { return __hip_atomic_load(p, __ATOMIC_RELAXED, __HIP_MEMORY_SCOPE_AGENT); }
__device__ __forceinline__ unsigned xb_add(unsigned* p, unsigned v) { return __hip_atomic_fetch_add(p, v, __ATOMIC_RELAXED, __HIP_MEMORY_SCOPE_AGENT); }
__device__ __forceinline__ unsigned xb_xcc_id() { return (unsigned)__builtin_amdgcn_s_getreg((3 << 11) | 20) & 0xFu; }
#define XB_SPIN(cond, bar) do { unsigned _sp = 0; while (cond) { __builtin_amdgcn_s_sleep(1); \
    if ((++_sp & 255u) == 0u) { if (xb_ld(&(bar)[XB_TMO])) break; if (_sp > XB_SPIN_CAP) { atomicAdd(&(bar)[XB_TMO], 1u); break; } } } } while (0)
struct XcdBarrier { unsigned* bar; unsigned x; volatile LAS unsigned* st; unsigned wave; };
__device__ __forceinline__ XcdBarrier xcd_barrier_post(unsigned* bar, volatile LAS unsigned* st) {
    XcdBarrier b; b.bar = bar; b.x = xb_xcc_id(); b.st = st; b.wave = (unsigned)__builtin_amdgcn_readfirstlane((int)(threadIdx.x >> 6));
    if (threadIdx.x == 0) (void)xb_add(&bar[XB_XCNT(b.x)], 1u);
    return b;
}
__device__ __forceinline__ void xcd_barrier_complete(unsigned* bar, unsigned x, unsigned& nloc, unsigned& nx) {
    const unsigned G = gridDim.x * gridDim.y * gridDim.z;
    unsigned sum, cnt, mine, sp = 0u;
    for (;;) {
        sum = 0u; cnt = 0u; mine = 0u;
#pragma unroll
        for (unsigned j = 0; j < 16; ++j) { const unsigned c = xb_ld(&bar[XB_XCNT(j)]); sum += c; cnt += (c > 0u) ? 1u : 0u; mine = (j == x) ? c : mine; }
        if (sum == G) break;
        __builtin_amdgcn_s_sleep(1);
        if ((++sp & 255u) == 0u) { if (xb_ld(&bar[XB_TMO])) break; if (sp > XB_SPIN_CAP) { atomicAdd(&bar[XB_TMO], 1u); break; } }
    }
    nloc = mine > 0u ? mine : 1u; nx = cnt > 0u ? cnt : 1u;
}
__device__ __forceinline__ void xcd_barrier(const XcdBarrier& b) {
    asm volatile("s_waitcnt vmcnt(0)" ::: "memory");
    __syncthreads();
    unsigned tx = b.wave * 64u + (unsigned)lane_id_now();
    if (tx == 0) {
        unsigned* bar = b.bar;
        __builtin_amdgcn_s_waitcnt(0);
        unsigned nloc = b.st[0], nx = b.st[1];
        if (nloc == 0u) { xcd_barrier_complete(bar, b.x, nloc, nx); b.st[0] = nloc; b.st[1] = nx; }
        const unsigned old = xb_add(&bar[XB_XSUB(b.x)], 1u);
        const unsigned gen = old / nloc;
        if (old + 1u == (gen + 1u) * nloc) {
            __builtin_amdgcn_fence(__ATOMIC_RELEASE, "agent");
            asm volatile("s_waitcnt vmcnt(0)" ::: "memory");
            const unsigned og = xb_add(&bar[XB_TOP], 1u);
            const unsigned tg = og / nx;
            if (og + 1u == (tg + 1u) * nx) xb_add(&bar[XB_TOPGEN], 1u);
            else XB_SPIN(xb_ld(&bar[XB_TOPGEN]) == tg, bar);
            __builtin_amdgcn_fence(__ATOMIC_ACQUIRE, "agent");
            xb_add(&bar[XB_XGEN(b.x)], 1u);
            asm volatile("s_waitcnt vmcnt(0)" ::: "memory");
        } else {
            XB_SPIN(xb_ld(&bar[XB_XGEN(b.x)]) == gen, bar);
            __builtin_amdgcn_fence(__ATOMIC_ACQUIRE, "agent");
            asm volatile("s_waitcnt vmcnt(0)" ::: "memory");
        }
    }
    __syncthreads();
}

struct Frame {
    LAS unsigned char* lds;
    int tid, lane, wave, blk, nblk;
    unsigned char* ws;
    const float* const* in;
    float* out;
};
#define WSP(T, off) ((T*)(F.ws + (off)))
#define OPAQUE(x) asm volatile("" : "+v"(x))
__device__ __forceinline__ float shflx(float v, int lane, int mask) { return __int_as_float(__builtin_amdgcn_ds_bpermute((lane ^ mask) << 2, __float_as_int(v))); }
__device__ __forceinline__ int shfl_up_i(int v, int lane, int d) { return __builtin_amdgcn_ds_bpermute(((lane >= d) ? lane - d : lane) << 2, v); }
__device__ __forceinline__ Frame local_frame(const Frame& G) { Frame F = G; int t = G.wave * 64 + lane_id_now(); F.tid = t; F.lane = t & 63; unsigned char* w = G.ws; asm volatile("" : "+s"(w)); F.ws = w; int bk = G.blk, nb = G.nblk; asm volatile("" : "+s"(bk), "+s"(nb)); F.blk = bk; F.nblk = nb; unsigned lb = (unsigned)(size_t)G.lds; asm volatile("" : "+s"(lb)); F.lds = (LAS unsigned char*)(size_t)lb; return F; }

constexpr bool PERM16 = (WMM == 3) && (UMM == 3);
__host__ __device__ __forceinline__ int slot_win(int c) { const int cc = c & 255; return (c & ~255) + ((cc >> 3) & 1) * 128 + (cc >> 6) * 32 + ((cc >> 2) & 1) * 16 + ((cc >> 4) & 3) * 4 + (cc & 3); }
__host__ __device__ __forceinline__ int slot_gu(int a, int n) { const int aa = a & 127; return (a >> 7) * 256 + ((aa >> 2) & 1) * 128 + (aa >> 5) * 32 + n * 16 + ((aa >> 3) & 3) * 4 + (aa & 3); }

__device__ __forceinline__ void tr_convert(const Frame& F, const float* src, int K, int N, bf16_t* dst, int ldd, int kofs, const float* scale, int mode, int radd, int& rot, int f8 = 0, float* cmax = nullptr) {
    LAS float* tile = (LAS float*)F.lds;
    const int tn = N / 128, ntile = (K / 64) * tn;
    const int tid = F.tid;
    int t = (F.blk + F.nblk - (rot % F.nblk)) % F.nblk;
    rot += ntile;
    if (t >= ntile) return;
    f32x4 cur[4], nxt[4];
#define TR_LOAD(dst_, tt) do { const int _k0 = ((tt) / tn) * 64, _n0 = ((tt) % tn) * 128; _Pragma("unroll") for (int _i = 0; _i < 4; ++_i) { const int _idx = tid + _i * NTHREADS; \
        dst_[_i] = *(const f32x4*)(src + (size_t)(_k0 + (_idx >> 5)) * N + _n0 + (_idx & 31) * 4); } } while (0)
    TR_LOAD(cur, t);
    for (; t < ntile; t += F.nblk) {
        const int k0 = (t / tn) * 64, n0 = (t % tn) * 128;
        const bool more = t + F.nblk < ntile;
        if (more) TR_LOAD(nxt, t + F.nblk);
        __syncthreads();
#pragma unroll
        for (int i = 0; i < 4; ++i) {
            const int idx = tid + i * NTHREADS, kk = idx >> 5, n4 = (idx & 31) * 4;
            const float s = scale ? scale[k0 + kk] : 1.0f;
            tile[kk * 129 + n4 + 0] = cur[i][0] * s; tile[kk * 129 + n4 + 1] = cur[i][1] * s; tile[kk * 129 + n4 + 2] = cur[i][2] * s; tile[kk * 129 + n4 + 3] = cur[i][3] * s;
        }
        __syncthreads();
        {
            const int nn = tid >> 2, kq = (tid & 3) * 16;
            const int n = n0 + nn;
            const int r = mode == 2 ? slot_win(n) : (mode ? (((n >> 4) << 5) + (n & 15) + radd) : n);
            if (f8 == 2) {
                float mx = 0.f;
#pragma unroll
                for (int j = 0; j < 16; ++j) mx = fmaxf(mx, fabsf(tile[(kq + j) * 129 + nn]));
                mx = fmaxf(mx, shflx(mx, F.lane, 1)); mx = fmaxf(mx, shflx(mx, F.lane, 2));
                if ((tid & 3) == 0) atomicMax((unsigned*)cmax + r, __float_as_uint(mx));
            } else if (f8 == 3) {
                const float cm = cmax[r], qs = cm > 0.f ? 127.0f / cm : 0.f;
                u32x4 o;
#pragma unroll
                for (int j = 0; j < 4; ++j) {
                    const int q0 = (int)rintf(tile[(kq + 4 * j) * 129 + nn] * qs), q1 = (int)rintf(tile[(kq + 4 * j + 1) * 129 + nn] * qs), q2 = (int)rintf(tile[(kq + 4 * j + 2) * 129 + nn] * qs), q3 = (int)rintf(tile[(kq + 4 * j + 3) * 129 + nn] * qs);
                    o[j] = (unsigned)(q0 & 255) | ((unsigned)(q1 & 255) << 8) | ((unsigned)(q2 & 255) << 16) | ((unsigned)(q3 & 255) << 24);
                }
                *(u32x4*)((unsigned char*)dst + (size_t)r * ldd + kofs + k0 + kq) = o;
            } else if (f8) {
                u32x4 o;
#pragma unroll
                for (int j = 0; j < 4; ++j) o[j] = pk4f8(32.f * tile[(kq + 4 * j) * 129 + nn], 32.f * tile[(kq + 4 * j + 1) * 129 + nn], 32.f * tile[(kq + 4 * j + 2) * 129 + nn], 32.f * tile[(kq + 4 * j + 3) * 129 + nn]);
                *(u32x4*)((unsigned char*)dst + (size_t)r * ldd + kofs + k0 + kq) = o;
            } else {
                u32x4 o0, o1;
#pragma unroll
                for (int j = 0; j < 4; ++j) { o0[j] = pk2(tile[(kq + 2 * j) * 129 + nn], tile[(kq + 2 * j + 1) * 129 + nn]); o1[j] = pk2(tile[(kq + 8 + 2 * j) * 129 + nn], tile[(kq + 8 + 2 * j + 1) * 129 + nn]); }
                bf16_t* dp = dst + (size_t)r * ldd + kofs + k0 + kq;
                *(u32x4*)dp = o0; *(u32x4*)(dp + 8) = o1;
            }
        }
        if (more) {
#pragma unroll
            for (int i = 0; i < 4; ++i) cur[i] = nxt[i];
        }
    }
#undef TR_LOAD
}

__device__ __forceinline__ void i8_convert_fullk(const Frame& F, const float* src, int N, unsigned char* dst, const float* scale, int mode, int radd, float* cmax, int& rot) {
    LAS float* red = (LAS float*)F.lds;
    const int ntile = N / 64, tid = F.tid;
    int t = (F.blk + F.nblk - (rot % F.nblk)) % F.nblk;
    rot += ntile;
    const int lr = tid >> 4, c4 = (tid & 15) * 4, lane = F.lane, w = F.wave;
    for (; t < ntile; t += F.nblk) {
        f32x4 cur[32];
        const unsigned vo = (unsigned)(lr * 32 * N + t * 64 + c4) * 4u;
#pragma unroll
        for (int p = 0; p < 32; ++p) cur[p] = *(const f32x4*)((const char*)(src + (size_t)p * N) + vo);
        f32x4 pm = zero4();
#pragma unroll
        for (int p4 = 0; p4 < 8; ++p4) {
            const f32x4 s4 = *(const f32x4*)(scale + lr * 32 + p4 * 4);
#pragma unroll
            for (int i = 0; i < 4; ++i) {
                const int p = p4 * 4 + i;
                cur[p] = cur[p] * s4[i];
                pm[0] = fmaxf(pm[0], fabsf(cur[p][0])); pm[1] = fmaxf(pm[1], fabsf(cur[p][1])); pm[2] = fmaxf(pm[2], fabsf(cur[p][2])); pm[3] = fmaxf(pm[3], fabsf(cur[p][3]));
            }
        }
#pragma unroll
        for (int i = 0; i < 4; ++i) { pm[i] = fmaxf(pm[i], shflx(pm[i], lane, 16)); pm[i] = fmaxf(pm[i], shflx(pm[i], lane, 32)); }
        __syncthreads();
        if (lane < 16) *(LAS f32x4*)(red + w * 64 + c4) = pm;
        __syncthreads();
        f32x4 cm = zero4();
#pragma unroll
        for (int ww = 0; ww < 8; ++ww) { const f32x4 v = *(LAS f32x4*)(red + ww * 64 + c4); cm[0] = fmaxf(cm[0], v[0]); cm[1] = fmaxf(cm[1], v[1]); cm[2] = fmaxf(cm[2], v[2]); cm[3] = fmaxf(cm[3], v[3]); }
#pragma unroll
        for (int i = 0; i < 4; ++i) {
            const float qs = cm[i] > 0.f ? 127.0f / cm[i] : 0.f;
            const int nn = t * 64 + c4 + i;
            const int r = PERM16 ? (mode ? slot_gu(nn, radd ? 1 : 0) : slot_win(nn)) : (mode ? (((nn >> 4) << 5) + (nn & 15) + radd) : nn);
            unsigned char* dp = dst + (size_t)r * 1024 + lr * 32;
#pragma unroll
            for (int h = 0; h < 2; ++h) {
                u32x4 o;
#pragma unroll
                for (int j = 0; j < 4; ++j) {
                    const int p = h * 16 + j * 4;
                    const int q0 = (int)rintf(cur[p][i] * qs), q1 = (int)rintf(cur[p + 1][i] * qs), q2 = (int)rintf(cur[p + 2][i] * qs), q3 = (int)rintf(cur[p + 3][i] * qs);
                    o[j] = (unsigned)(q0 & 255) | ((unsigned)(q1 & 255) << 8) | ((unsigned)(q2 & 255) << 16) | ((unsigned)(q3 & 255) << 24);
                }
                *(u32x4*)(dp + h * 16) = o;
            }
            if (lr == 0) cmax[r] = cm[i];
        }
    }
}

__device__ __forceinline__ void s5_tables(const Frame& F, int layer, int g) {
    LAS float* L = (LAS float*)F.lds;
    LAS float* apr = L;
    LAS float* api = L + 9 * 64;
    LAS float* bbr = L + 18 * 64;
    LAS float* bbi = bbr + 1024;
    LAS float* cr = bbi + 1024;
    LAS float* ci = cr + 1024;
    LAS float* kl = ci + 1024;
    const float* lam_re = F.in[5] + ((size_t)layer * NG + g) * NP;
    const float* lam_im = F.in[6] + ((size_t)layer * NG + g) * NP;
    const float log_dt = F.in[7][layer * NG + g];
    const float* b_re = F.in[8] + ((size_t)layer * NG + g) * NP * NH;
    const float* b_im = F.in[9] + ((size_t)layer * NG + g) * NP * NH;
    const float* c_re = F.in[10] + ((size_t)layer * NG + g) * NH * NP;
    const float* c_im = F.in[11] + ((size_t)layer * NG + g) * NH * NP;
    __syncthreads();
    if (F.tid < 64) {
        const int p = F.tid;
        const float lr = lam_re[p], li = lam_im[p], dt = expf(log_dt);
        const float mag = expf(lr * dt); float sn, cs; sincosf(li * dt, &sn, &cs);
        const float ar = mag * cs, ai = mag * sn;
        const float den = lr * lr + li * li, nr = ar - 1.0f;
        const float cfr = (nr * lr + ai * li) / den, cfi = (ai * lr - nr * li) / den;
        float pr = 1.0f, pi = 0.0f;
        for (int j = 0; j <= 8; ++j) { apr[j * 64 + p] = pr; api[j * 64 + p] = pi; const float t = pr * ar - pi * ai; pi = pr * ai + pi * ar; pr = t; }
        float qr = apr[8 * 64 + p], qi = api[8 * 64 + p];
        f32x2 w8; w8[0] = qr; w8[1] = qi;
        WSP(f32x2, WS_W8)[((size_t)layer * NG + g) * 64 + p] = w8;
        { const float m2 = expf(256.0f * lr * dt); float s2, c2; sincosf(256.0f * (li * dt), &s2, &c2); qr = m2 * c2; qi = m2 * s2; }
        f32x2 w256; w256[0] = qr; w256[1] = qi;
        WSP(f32x2, WS_W256)[((size_t)layer * NG + g) * 64 + p] = w256;
        for (int h = 0; h < 16; ++h) {
            const float br = b_re[p * 16 + h], bi = b_im[p * 16 + h];
            bbr[p * 16 + h] = cfr * br - cfi * bi;
            bbi[p * 16 + h] = cfr * bi + cfi * br;
        }
    }
    for (int i = F.tid; i < 1024; i += NTHREADS) { cr[i] = c_re[i]; ci[i] = c_im[i]; }
    __syncthreads();
    for (int i = F.tid; i < 2048; i += NTHREADS) {
        const int j = i >> 8, h = (i >> 4) & 15, h2 = i & 15;
        float acc = 0.f;
        for (int p = 0; p < 64; ++p) {
            const float wr = apr[j * 64 + p] * bbr[p * 16 + h2] - api[j * 64 + p] * bbi[p * 16 + h2];
            const float wi = apr[j * 64 + p] * bbi[p * 16 + h2] + api[j * 64 + p] * bbr[p * 16 + h2];
            acc += cr[h * 64 + p] * wr - ci[h * 64 + p] * wi;
        }
        kl[i] = acc;
    }
    __syncthreads();
    bf16_t* T = WSP(bf16_t, WS_S5T) + ((size_t)layer * NG + g) * 3 * 16384;
    for (int i = F.tid; i < 16384; i += NTHREADS) {
        const int row = i >> 7, col = i & 127;
        { const int p = row & 63, kt = col >> 4, h2 = col & 15, j = 7 - kt;
          const float wr = apr[j * 64 + p] * bbr[p * 16 + h2] - api[j * 64 + p] * bbi[p * 16 + h2];
          const float wi = apr[j * 64 + p] * bbi[p * 16 + h2] + api[j * 64 + p] * bbr[p * 16 + h2];
          T[i] = f2bf(row < 64 ? wr : wi); }
        { const int t = row >> 4, h = row & 15, kt = col >> 4, h2 = col & 15;
          T[16384 + i] = f2bf(kt <= t ? kl[((t - kt) << 8) + (h << 4) + h2] : 0.f); }
        { const int t = row >> 4, h = row & 15, p = col & 63, j = t + 1;
          const float wr = cr[h * 64 + p] * apr[j * 64 + p] - ci[h * 64 + p] * api[j * 64 + p];
          const float wi = cr[h * 64 + p] * api[j * 64 + p] + ci[h * 64 + p] * apr[j * 64 + p];
          T[32768 + i] = f2bf(col < 64 ? wr : -wi); }
    }
}

__device__ __forceinline__ void quant_row_store(const f32x4 (&v)[4], float ss, int lane, unsigned char* q8row, float* sa_row) {
    float mx = 0.f;
#pragma unroll
    for (int i = 0; i < 4; ++i) mx = fmaxf(fmaxf(mx, fmaxf(fabsf(v[i][0]), fabsf(v[i][1]))), fmaxf(fabsf(v[i][2]), fabsf(v[i][3])));
#pragma unroll
    for (int o = 32; o >= 1; o >>= 1) mx = fmaxf(mx, shflx(mx, lane, o));
    const float qs = mx > 0.f ? 127.0f / mx : 0.f;
#pragma unroll
    for (int i = 0; i < 4; ++i) {
        const int q0 = (int)rintf(v[i][0] * qs), q1 = (int)rintf(v[i][1] * qs), q2 = (int)rintf(v[i][2] * qs), q3 = (int)rintf(v[i][3] * qs);
        *(unsigned*)(q8row + i * 256 + lane * 4) = (unsigned)(q0 & 255) | ((unsigned)(q1 & 255) << 8) | ((unsigned)(q2 & 255) << 16) | ((unsigned)(q3 & 255) << 24);
    }
    if (lane == 0) *sa_row = mx * rsqrtf(ss * (1.0f / D) + EPS) * (1.0f / 127.0f);
}
__device__ __forceinline__ void prologue(const Frame& G) {
    const Frame F = local_frame(G);
    int rot = 0;
    for (int l = 0; l < DEPTH; ++l) {
        for (int r_ = 0; r_ <= REPS(15); ++r_) if (WMM == 3) i8_convert_fullk(F, F.in[3] + (size_t)l * D * DIN, DIN, WSP(unsigned char, WS_WIN + l * SZ_WIN), F.in[2] + l * D, 0, 0, WSP(float, WS_CMAX) + CMAX_WIN + l * DIN, rot);
        else for (int r_ = 0; r_ <= REPS(16); ++r_) tr_convert(F, F.in[3] + (size_t)l * D * DIN, D, DIN, WSP(bf16_t, WS_WIN + l * SZ_WIN), D, 0, F.in[2] + l * D, 0, 0, rot);
        for (int r_ = 0; r_ <= REPS(16); ++r_) tr_convert(F, F.in[13] + (size_t)l * 512 * 512, 512, 512, WSP(bf16_t, WS_WGLU + l * SZ_WGLU), 512, 0, nullptr, 0, 0, rot);
        for (int r_ = 0; r_ <= REPS(16); ++r_) tr_convert(F, F.in[15] + (size_t)l * 512 * D, 512, D, WSP(bf16_t, WS_WPROJ + l * SZ_WPROJ), D, 0, nullptr, 2, 0, rot);
        for (int r_ = 0; r_ <= REPS(16); ++r_) tr_convert(F, F.in[23] + (size_t)l * 512 * D, 512, D, WSP(bf16_t, WS_WPROJ + l * SZ_WPROJ), D, 512, nullptr, 2, 0, rot);
        for (int r_ = 0; r_ <= REPS(16); ++r_) tr_convert(F, F.in[24] + (size_t)l * D * D, D, D, WSP(bf16_t, WS_WOUT + l * SZ_WPROJ), D, 0, nullptr, 0, 0, rot, (l >= WOUT_F8_FROM) ? 1 : 0);
    }
    constexpr int GUM = (UMM == 3) ? 2 : (UMM == 1 ? 1 : 0);
    float* cmx = WSP(float, WS_CMAX);
    for (int j = 0; j < 2; ++j) {
        const float* fn = F.in[25] + (size_t)(2 * j) * D;
        if (UMM == 3) {
            for (int r_ = 0; r_ <= REPS(15); ++r_) i8_convert_fullk(F, F.in[26] + (size_t)j * D * DFF, DFF, WSP(unsigned char, WS_DGU + j * SZ_DGU), fn, 1, 0, cmx + j * 2 * DFF, rot);
            for (int r_ = 0; r_ <= REPS(15); ++r_) i8_convert_fullk(F, F.in[27] + (size_t)j * D * DFF, DFF, WSP(unsigned char, WS_DGU + j * SZ_DGU), fn, 1, 16, cmx + j * 2 * DFF, rot);
        } else {
        tr_convert(F, F.in[26] + (size_t)j * D * DFF, D, DFF, WSP(bf16_t, WS_DGU + j * SZ_DGU), D, 0, fn, 1, 0, rot, GUM, cmx + j * 2 * DFF);
        tr_convert(F, F.in[27] + (size_t)j * D * DFF, D, DFF, WSP(bf16_t, WS_DGU + j * SZ_DGU), D, 0, fn, 1, 16, rot, GUM, cmx + j * 2 * DFF);
        }
        for (int r_ = 0; r_ <= REPS(16); ++r_) tr_convert(F, F.in[28] + (size_t)j * DFF * D, DFF, D, WSP(bf16_t, WS_DDN + j * SZ_DDN), DFF, 0, nullptr, 0, 0, rot, (j == 0 ? DESZ_D : DESZ_D2) == 1);
        const float* fm = F.in[25] + (size_t)(2 * j + 1) * D;
        for (int e = 0; e < NEXP; ++e) {
            if (UMM == 3) {
                for (int r_ = 0; r_ <= REPS(15); ++r_) i8_convert_fullk(F, F.in[31] + ((size_t)j * NEXP + e) * D * EFF, EFF, WSP(unsigned char, WS_MGU + (j * NEXP + e) * SZ_MGU), fm, 1, 0, cmx + CMAX_MOE + (j * NEXP + e) * 2 * EFF, rot);
                for (int r_ = 0; r_ <= REPS(15); ++r_) i8_convert_fullk(F, F.in[32] + ((size_t)j * NEXP + e) * D * EFF, EFF, WSP(unsigned char, WS_MGU + (j * NEXP + e) * SZ_MGU), fm, 1, 16, cmx + CMAX_MOE + (j * NEXP + e) * 2 * EFF, rot);
            } else {
            tr_convert(F, F.in[31] + ((size_t)j * NEXP + e) * D * EFF, D, EFF, WSP(bf16_t, WS_MGU + (j * NEXP + e) * SZ_MGU), D, 0, fm, 1, 0, rot, GUM, cmx + CMAX_MOE + (j * NEXP + e) * 2 * EFF);
            tr_convert(F, F.in[32] + ((size_t)j * NEXP + e) * D * EFF, D, EFF, WSP(bf16_t, WS_MGU + (j * NEXP + e) * SZ_MGU), D, 0, fm, 1, 16, rot, GUM, cmx + CMAX_MOE + (j * NEXP + e) * 2 * EFF);
            }
            for (int r_ = 0; r_ <= REPS(16); ++r_) tr_convert(F, F.in[33] + ((size_t)j * NEXP + e) * EFF * D, EFF, D, WSP(bf16_t, WS_MDN + (j * NEXP + e) * SZ_MDN), EFF, 0, nullptr, 0, 0, rot, DESZ_M == 1);
        }
    }
    for (int r_ = 0; r_ <= REPS(17); ++r_) for (int u = F.blk; u < DEPTH * NG; u += F.nblk) s5_tables(F, u / NG, u % NG);
    {
        bf16_t* lw = WSP(bf16_t, WS_LRUW);
        for (int i = F.blk * NTHREADS + F.tid; i < DEPTH * 8 * 2 * 4096; i += F.nblk * NTHREADS) {
            const int h = i & 63, k = (i >> 6) & 63, gt = (i >> 12) & 1, lh = i >> 13;
            lw[i] = f2bf(F.in[gt ? 20 : 18][(size_t)lh * 4096 + h * 64 + k]);
        }
    }
    float* hs = WSP(float, WS_HS); bf16_t* hsb = WSP(bf16_t, WS_HSB); float* rsp = WSP(float, WS_RSP);
    for (int r_ = 0; r_ <= REPS(18); ++r_) for (int row = F.blk * 8 + F.wave; row < MP; row += F.nblk * 8) {
        const float* src = row < NTOK ? F.in[0] + (size_t)row * D : (row < NV ? F.in[1] + (size_t)(row - NTOK) * D : nullptr);
        float ss = 0.f; f32x4 vv[4];
#pragma unroll
        for (int i = 0; i < 4; ++i) {
            const int k = i * 256 + F.lane * 4;
            f32x4 v = src ? *(const f32x4*)(src + k) : zero4();
            vv[i] = v;
            if (!SKIP_HS0 || row >= NV) *(f32x4*)(hs + (size_t)row * D + k) = v;
            if (NEED_HSB) { u32x2 o; o[0] = pk2(v[0], v[1]); o[1] = pk2(v[2], v[3]); *(u32x2*)(hsb + (size_t)row * D + k) = o; }
            ss += v[0] * v[0] + v[1] * v[1] + v[2] * v[2] + v[3] * v[3];
        }
#pragma unroll
        for (int o = 32; o >= 1; o >>= 1) ss += shflx(ss, F.lane, o);
        if (NEED_HSB && F.lane < 16) rsp[(size_t)row * 16 + F.lane] = (F.lane == 0) ? ss : 0.f;
        if (WMM == 3 && row < NV) quant_row_store(vv, ss, F.lane, WSP(unsigned char, WS_HSB8) + (size_t)row * D, WSP(float, WS_SA) + row);
    }
}

__device__ __forceinline__ void prologue2(const Frame& G) {
    const Frame F = local_frame(G);
    int rot = 0;
    float* cmx = WSP(float, WS_CMAX);
    if (WMM == 3) for (int l = 0; l < DEPTH; ++l) tr_convert(F, F.in[3] + (size_t)l * D * DIN, D, DIN, WSP(bf16_t, WS_WIN + l * SZ_WIN), D, 0, F.in[2] + l * D, 0, 0, rot, 3, cmx + CMAX_WIN + l * DIN);
    if (UMM == 3) for (int j = 0; j < 2; ++j) {
        const float* fn = F.in[25] + (size_t)(2 * j) * D;
        tr_convert(F, F.in[26] + (size_t)j * D * DFF, D, DFF, WSP(bf16_t, WS_DGU + j * SZ_DGU), D, 0, fn, 1, 0, rot, 3, cmx + j * 2 * DFF);
        tr_convert(F, F.in[27] + (size_t)j * D * DFF, D, DFF, WSP(bf16_t, WS_DGU + j * SZ_DGU), D, 0, fn, 1, 16, rot, 3, cmx + j * 2 * DFF);
        const float* fm = F.in[25] + (size_t)(2 * j + 1) * D;
        for (int e = 0; e < NEXP; ++e) {
            tr_convert(F, F.in[31] + ((size_t)j * NEXP + e) * D * EFF, D, EFF, WSP(bf16_t, WS_MGU + (j * NEXP + e) * SZ_MGU), D, 0, fm, 1, 0, rot, 3, cmx + CMAX_MOE + (j * NEXP + e) * 2 * EFF);
            tr_convert(F, F.in[32] + ((size_t)j * NEXP + e) * D * EFF, D, EFF, WSP(bf16_t, WS_MGU + (j * NEXP + e) * SZ_MGU), D, 0, fm, 1, 16, rot, 3, cmx + CMAX_MOE + (j * NEXP + e) * 2 * EFF);
        }
    }
}
__device__ __forceinline__ void qnorm_rows(const Frame& G, int r_lo = -1, int r_hi = NV) {
    const Frame F = local_frame(G);
    const float* hs = WSP(float, WS_HS); unsigned char* q8 = WSP(unsigned char, WS_HSB8); float* sa = WSP(float, WS_SA);
    const int l16 = F.lane & 15;
    for (int r0 = (r_lo < 0 ? (F.blk * 8 + F.wave) * 4 : r_lo + F.wave * 4); r0 < r_hi; r0 += (r_lo < 0 ? F.nblk * 32 : 32)) {
        const int row = r0 + (F.lane >> 4); const bool rv = row < r_hi;
        f32x4 hv[16]; float ss = 0.f, mx = 0.f;
#pragma unroll
        for (int i = 0; i < 16; ++i) hv[i] = rv ? *(const f32x4*)(hs + (size_t)row * D + i * 64 + l16 * 4) : zero4();
#pragma unroll
        for (int i = 0; i < 16; ++i) { const f32x4 v = hv[i]; ss += v[0] * v[0] + v[1] * v[1] + v[2] * v[2] + v[3] * v[3]; mx = fmaxf(fmaxf(mx, fmaxf(fabsf(v[0]), fabsf(v[1]))), fmaxf(fabsf(v[2]), fabsf(v[3]))); }
#pragma unroll
        for (int o = 8; o >= 1; o >>= 1) { ss += shflx(ss, F.lane, o); mx = fmaxf(mx, shflx(mx, F.lane, o)); }
        if (rv) {
            const float ri = rsqrtf(ss * (1.0f / D) + EPS), qs = mx > 0.f ? 127.0f / mx : 0.f;
#pragma unroll
            for (int i = 0; i < 16; ++i) {
                const f32x4 v = hv[i];
                const int q0 = (int)rintf(v[0] * qs), q1 = (int)rintf(v[1] * qs), q2 = (int)rintf(v[2] * qs), q3 = (int)rintf(v[3] * qs);
                *(unsigned*)(q8 + (size_t)row * D + i * 64 + l16 * 4) = (unsigned)(q0 & 255) | ((unsigned)(q1 & 255) << 8) | ((unsigned)(q2 & 255) << 16) | ((unsigned)(q3 & 255) << 24);
            }
            if (l16 == 0) sa[row] = mx * ri * (1.0f / 127.0f);
        }
    }
}

struct Side { f32x4 a, b; };
struct Col { f32x4 c0, c1; };
struct APlain { const bf16_t* A; int lda; __device__ __forceinline__ const bf16_t* row(int r) const { return A + (size_t)r * lda; } };
struct AGather { const bf16_t* A; int lda; const int* idx; __device__ __forceinline__ const bf16_t* row(int r) const { return A + (size_t)idx[r] * lda; } };
struct BPlain { const bf16_t* Bt; __device__ __forceinline__ const bf16_t* base(int) const { return Bt; } };
struct BExpert { const bf16_t* Bt; size_t estride; const int* texp; __device__ __forceinline__ const bf16_t* base(int m0) const { return Bt + (size_t)texp[m0 >> 8] * estride; } };

template <class AP, class BP, class Epi>
__device__ __forceinline__ void wgemm_tile(const AP& ap, const BP& bp, int K, int m0, int n0, const Epi& E, int lane) {
    const int fr = lane & 15, fq = lane >> 4;
    const bf16_t* a_ptr[2]; const bf16_t* b_ptr[4];
#pragma unroll
    for (int mi = 0; mi < 2; ++mi) a_ptr[mi] = ap.row(m0 + 16 * mi + fr) + 8 * fq;
    const bf16_t* Bt = bp.base(m0);
#pragma unroll
    for (int ni = 0; ni < 4; ++ni) b_ptr[ni] = Bt + (size_t)(n0 + 16 * ni + fr) * K + 8 * fq;
    f32x4 acc[2][4];
#pragma unroll
    for (int mi = 0; mi < 2; ++mi)
#pragma unroll
        for (int ni = 0; ni < 4; ++ni) acc[mi][ni] = zero4();
    const int kh = Epi::MIDK ? K / 2 : K;
#pragma unroll 1
    for (int seg = 0; seg < (Epi::MIDK ? 2 : 1); ++seg) {
        const int k0 = seg * kh, k1 = k0 + kh;
#pragma unroll 4
        for (int k = k0; k < k1; k += 32) {
            bf16x8 af[2], bf[4];
#pragma unroll
            for (int mi = 0; mi < 2; ++mi) af[mi] = *(const bf16x8*)(a_ptr[mi] + k);
#pragma unroll
            for (int ni = 0; ni < 4; ++ni) bf[ni] = *(const bf16x8*)(b_ptr[ni] + k);
#pragma unroll
            for (int mi = 0; mi < 2; ++mi)
#pragma unroll
                for (int ni = 0; ni < 4; ++ni) acc[mi][ni] = __builtin_amdgcn_mfma_f32_16x16x32_bf16(bf[ni], af[mi], acc[mi][ni], 0, 0, 0);
        }
        if constexpr (Epi::MIDK) {
            if (seg == 0) {
#pragma unroll
                for (int mi = 0; mi < 2; ++mi)
#pragma unroll
                    for (int q = 0; q < 2; ++q) E.mid(m0 + 16 * mi + fr, n0 + 32 * q, fq, acc[mi][2 * q], acc[mi][2 * q + 1]);
            }
        }
    }
    Col cl[2]; float rsv[2]; Side sd[2][2];
#pragma unroll
    for (int q = 0; q < 2; ++q) cl[q] = E.col(n0 + 32 * q, fq);
#pragma unroll
    for (int mi = 0; mi < 2; ++mi) {
        rsv[mi] = E.row_scale(m0 + 16 * mi + fr, 0);
#pragma unroll
        for (int q = 0; q < 2; ++q) sd[mi][q] = E.side(m0 + 16 * mi + fr, n0 + 32 * q, fq, 0);
    }
#pragma unroll
    for (int mi = 0; mi < 2; ++mi) {
        const int row = m0 + 16 * mi + fr;
        const float rs = rsv[mi];
        float ss = 0.f;
#pragma unroll
        for (int q = 0; q < 2; ++q) ss += E.store(row, rs, n0 + 32 * q, fq, acc[mi][2 * q], acc[mi][2 * q + 1], sd[mi][q], cl[q]);
        if constexpr (Epi::ROWSS) {
            ss += shflx(ss, lane, 16); ss += shflx(ss, lane, 32);
            if (fq == 0) E.write_ss(row, n0 >> 6, ss);
        }
    }
}
template <class AP, class BP, class Epi>
__device__ __forceinline__ void wgemm_all(const Frame& G, const AP& ap, const BP& bp, int m_lo, int m_hi, int N, int K, const Epi& E) {
    const Frame F = local_frame(G);
    const int tn = N / 64, tm = (m_hi - m_lo) / 32, nt = tm * tn;
    for (int t = F.blk * 8 + F.wave; t < nt; t += F.nblk * 8) wgemm_tile(ap, bp, K, m_lo + (t / tn) * 32, (t % tn) * 64, E, F.lane);
}

__device__ __forceinline__ float rinv_from_partials(const float* rsp, int row) {
    const f32x4* p = (const f32x4*)(rsp + (size_t)row * 16);
    const f32x4 a = p[0], b = p[1], c = p[2], d = p[3];
    const float s = ((a[0] + a[1]) + (a[2] + a[3])) + ((b[0] + b[1]) + (b[2] + b[3])) + ((c[0] + c[1]) + (c[2] + c[3])) + ((d[0] + d[1]) + (d[2] + d[3]));
    return rsqrtf(s * (1.0f / D) + EPS);
}
__device__ __forceinline__ void st4bf(bf16_t* p, f32x4 v) { u32x2 o; o[0] = pk2(v[0], v[1]); o[1] = pk2(v[2], v[3]); *(u32x2*)p = o; }
__device__ __forceinline__ f32x4 ld4bf(const bf16_t* p) { const u32x2 o = *(const u32x2*)p; f32x4 v; v[0] = __uint_as_float(o[0] << 16); v[1] = __uint_as_float(o[0] & 0xffff0000u); v[2] = __uint_as_float(o[1] << 16); v[3] = __uint_as_float(o[1] & 0xffff0000u); return v; }

__device__ __forceinline__ f32x4 bits4(u32x2 lo, u32x2 hi) { f32x4 r; r[0] = __uint_as_float(lo[0]); r[1] = __uint_as_float(lo[1]); r[2] = __uint_as_float(hi[0]); r[3] = __uint_as_float(hi[1]); return r; }
__device__ __forceinline__ f32x4 unpk4(float w0, float w1) { const unsigned a = __float_as_uint(w0), b = __float_as_uint(w1); f32x4 v; v[0] = __uint_as_float(a << 16); v[1] = __uint_as_float(a & 0xffff0000u); v[2] = __uint_as_float(b << 16); v[3] = __uint_as_float(b & 0xffff0000u); return v; }

struct Col16 { f32x4 b[4]; };
__device__ __forceinline__ void st8bf(bf16_t* p, f32x4 a, f32x4 b) { u32x4 o; o[0] = pk2(a[0], a[1]); o[1] = pk2(a[2], a[3]); o[2] = pk2(b[0], b[1]); o[3] = pk2(b[2], b[3]); *(u32x4*)p = o; }
constexpr bool GATES8 = PERM16;
__device__ __forceinline__ unsigned pk4u8(f32x4 g) {
    unsigned o = 0u;
    o = __builtin_amdgcn_cvt_pk_u8_f32(rintf(fmaxf(g[0] * 255.0f, 1.0f)), 0, o); o = __builtin_amdgcn_cvt_pk_u8_f32(rintf(fmaxf(g[1] * 255.0f, 1.0f)), 1, o);
    o = __builtin_amdgcn_cvt_pk_u8_f32(rintf(fmaxf(g[2] * 255.0f, 1.0f)), 2, o); o = __builtin_amdgcn_cvt_pk_u8_f32(rintf(fmaxf(g[3] * 255.0f, 1.0f)), 3, o);
    return o;
}
__device__ __forceinline__ f32x4 un4u8(unsigned w) { f32x4 o; o[0] = (float)(w & 255u); o[1] = (float)((w >> 8) & 255u); o[2] = (float)((w >> 16) & 255u); o[3] = (float)(w >> 24); return o; }
__device__ __forceinline__ void ld16u8(const unsigned char* p, f32x4 (&o)[4]) { const u32x4 a = *(const u32x4*)p; o[0] = un4u8(a[0]); o[1] = un4u8(a[1]); o[2] = un4u8(a[2]); o[3] = un4u8(a[3]); }
struct EpiWin {
    static constexpr bool MIDK = false, ROWSS = false, P16 = PERM16; static constexpr int EB = 2;
    __device__ __forceinline__ Col16 col16(int pn, int wc, int fq) const { Col16 c; const int col0 = pn * 256 + wc * 64 + fq * 16;
        if (col0 >= 1536) { c.b[0] = *(const f32x4*)(mbias + col0 - 1536); c.b[1] = *(const f32x4*)(mbias + col0 - 1536 + 4); c.b[2] = *(const f32x4*)(mbias + col0 - 1536 + 8); c.b[3] = *(const f32x4*)(mbias + col0 - 1536 + 12); }
        else { c.b[0] = (f32x4){0.f, 0.f, 0.f, 0.f}; c.b[1] = c.b[0]; c.b[2] = c.b[0]; c.b[3] = c.b[0]; } return c; }
    __device__ __forceinline__ f32x4 act4(int seg, f32x4 v, f32x4 b) const {
        if (seg < 2) return v;
        f32x4 o;
        if (seg == 2) { o[0] = gelu_tanh(v[0]); o[1] = gelu_tanh(v[1]); o[2] = gelu_tanh(v[2]); o[3] = gelu_tanh(v[3]); }
        else { o[0] = sigmoidf_(v[0] + b[0]); o[1] = sigmoidf_(v[1] + b[1]); o[2] = sigmoidf_(v[2] + b[2]); o[3] = sigmoidf_(v[3] + b[3]); }
        return o; }
    __device__ __forceinline__ bf16_t* outp(int seg, int row, int col0) const { return seg == 0 ? us5 + (size_t)row * 512 + col0 : seg == 1 ? xlru + (size_t)row * 512 + (col0 - 512) : seg == 2 ? gg + (size_t)row * 512 + (col0 - 1024) : gates + (size_t)row * 2048 + (col0 - 1536); }
    __device__ __forceinline__ void store16(int row, float rs, int pn, int wc, int fq, f32x4 v00, f32x4 v01, f32x4 v10, f32x4 v11, const Col16& c) const {
        const int col0 = pn * 256 + wc * 64 + fq * 16, seg = col0 < 1536 ? (col0 >> 9) : 3;
        if (GATES8 && seg == 3) {
            u32x4 o; o[0] = pk4u8(act4(3, v00 * rs, c.b[0])); o[1] = pk4u8(act4(3, v01 * rs, c.b[1])); o[2] = pk4u8(act4(3, v10 * rs, c.b[2])); o[3] = pk4u8(act4(3, v11 * rs, c.b[3]));
            *(u32x4*)((unsigned char*)gates + (size_t)row * 2048 + (col0 - 1536)) = o;
            return;
        }
        bf16_t* p = outp(seg, row, col0);
        st8bf(p, act4(seg, v00 * rs, c.b[0]), act4(seg, v01 * rs, c.b[1])); st8bf(p + 8, act4(seg, v10 * rs, c.b[2]), act4(seg, v11 * rs, c.b[3]));
    }
    __device__ __forceinline__ void rider_pair(int row, float rs, int pn, int bj, int wc, int fq, f32x4 v0, f32x4 v1) const {
        const int col0 = pn * 256 + wc * 64 + fq * 16, seg = col0 < 1536 ? (col0 >> 9) : 3;
        f32x4 b0 = (f32x4){0.f, 0.f, 0.f, 0.f}, b1 = b0;
        if (seg == 3) { b0 = *(const f32x4*)(mbias + col0 - 1536 + bj * 8); b1 = *(const f32x4*)(mbias + col0 - 1536 + bj * 8 + 4); }
        if (GATES8 && seg == 3) { u32x2 o; o[0] = pk4u8(act4(3, v0 * rs, b0)); o[1] = pk4u8(act4(3, v1 * rs, b1)); *(u32x2*)((unsigned char*)gates + (size_t)row * 2048 + (col0 - 1536) + bj * 8) = o; return; }
        st8bf(outp(seg, row, col0) + bj * 8, act4(seg, v0 * rs, b0), act4(seg, v1 * rs, b1));
    }
    const float* rsp; bf16_t* us5; bf16_t* xlru; bf16_t* gg; bf16_t* gates; const float* mbias;
    __device__ __forceinline__ float row_scale(int row, int) const { return WMM == 3 ? 1.0f : rinv_from_partials(rsp, row); }
    __device__ __forceinline__ Col col(int cb, int fq) const { Col c; if (cb >= 1536) { c.c0 = *(const f32x4*)(mbias + (cb - 1536) + 4 * fq); c.c1 = *(const f32x4*)(mbias + (cb - 1536) + 16 + 4 * fq); } else { c.c0 = (f32x4){0.f, 0.f, 0.f, 0.f}; c.c1 = c.c0; } return c; }
    __device__ __forceinline__ Side side(int, int, int, int) const { Side s; s.a = (f32x4){0.f, 0.f, 0.f, 0.f}; s.b = s.a; return s; }
    __device__ __forceinline__ void one(int row, float rs, int c, f32x4 v, f32x4 b) const {
        v = v * rs;
        if (c < 512) st4bf(us5 + (size_t)row * 512 + c, v);
        else if (c < 1024) st4bf(xlru + (size_t)row * 512 + (c - 512), v);
        else if (c < 1536) { f32x4 o; o[0] = gelu_tanh(v[0]); o[1] = gelu_tanh(v[1]); o[2] = gelu_tanh(v[2]); o[3] = gelu_tanh(v[3]); st4bf(gg + (size_t)row * 512 + (c - 1024), o); }
        else { f32x4 o; o[0] = sigmoidf_(v[0] + b[0]); o[1] = sigmoidf_(v[1] + b[1]); o[2] = sigmoidf_(v[2] + b[2]); o[3] = sigmoidf_(v[3] + b[3]); st4bf(gates + (size_t)row * 2048 + (c - 1536), o); }
    }
    __device__ __forceinline__ float store(int row, float rs, int cb, int fq, f32x4 v0, f32x4 v1, const Side&, const Col& cl) const { one(row, rs, cb + 4 * fq, v0, cl.c0); one(row, rs, cb + 16 + 4 * fq, v1, cl.c1); return 0.f; }
};
struct EpiGlu {
    static constexpr bool MIDK = false, ROWSS = false, P16 = false; static constexpr int EB = 2;
    const bf16_t* ys5; const float* bglu; bf16_t* solo;
    __device__ __forceinline__ float row_scale(int, int) const { return 1.f; }
    __device__ __forceinline__ Col col(int cb, int fq) const { Col c; c.c0 = *(const f32x4*)(bglu + cb + 4 * fq); c.c1 = *(const f32x4*)(bglu + cb + 16 + 4 * fq); return c; }
    __device__ __forceinline__ Side side(int row, int cb, int fq, int) const { Side s; s.a = bits4(*(const u32x2*)(ys5 + (size_t)row * 512 + cb + 4 * fq), *(const u32x2*)(ys5 + (size_t)row * 512 + cb + 16 + 4 * fq)); s.b = (f32x4){0.f, 0.f, 0.f, 0.f}; return s; }
    __device__ __forceinline__ void one(int row, int c, f32x4 v, f32x4 y, f32x4 b) const {
        f32x4 o; o[0] = y[0] * sigmoidf_(v[0] + b[0]); o[1] = y[1] * sigmoidf_(v[1] + b[1]); o[2] = y[2] * sigmoidf_(v[2] + b[2]); o[3] = y[3] * sigmoidf_(v[3] + b[3]);
        st4bf(solo + (size_t)row * D + c, o);
    }
    __device__ __forceinline__ float store(int row, float, int cb, int fq, f32x4 v0, f32x4 v1, const Side& s, const Col& cl) const { one(row, cb + 4 * fq, v0, unpk4(s.a[0], s.a[1]), cl.c0); one(row, cb + 16 + 4 * fq, v1, unpk4(s.a[2], s.a[3]), cl.c1); return 0.f; }
};
struct EpiProj {
    static constexpr bool MIDK = true, ROWSS = false, P16 = false; static constexpr int EB = 2;
    const bf16_t* gates; bf16_t* y;
    __device__ __forceinline__ float row_scale(int, int) const { return 1.f; }
    __device__ __forceinline__ Col col(int, int) const { Col c; c.c0 = (f32x4){0.f, 0.f, 0.f, 0.f}; c.c1 = c.c0; return c; }
    __device__ __forceinline__ Side side(int row, int cb, int fq, int) const { Side s; s.a = bits4(*(const u32x2*)(gates + (size_t)row * 2048 + 1024 + cb + 4 * fq), *(const u32x2*)(gates + (size_t)row * 2048 + 1024 + cb + 16 + 4 * fq)); s.b = s.a; return s; }
    __device__ __forceinline__ void mid1(int row, int c, f32x4& v) const {
        const f32x4 g0 = ld4bf(gates + (size_t)row * 2048 + c), g1 = ld4bf(gates + (size_t)row * 2048 + 1024 + c);
        v[0] *= g0[0] / g1[0]; v[1] *= g0[1] / g1[1]; v[2] *= g0[2] / g1[2]; v[3] *= g0[3] / g1[3];
    }
    __device__ __forceinline__ void mid(int row, int cb, int fq, f32x4& v0, f32x4& v1) const { mid1(row, cb + 4 * fq, v0); mid1(row, cb + 16 + 4 * fq, v1); }
    __device__ __forceinline__ float store(int row, float, int cb, int fq, f32x4 v0, f32x4 v1, const Side& s, const Col&) const {
        st4bf(y + (size_t)row * D + cb + 4 * fq, v0 * unpk4(s.a[0], s.a[1])); st4bf(y + (size_t)row * D + cb + 16 + 4 * fq, v1 * unpk4(s.a[2], s.a[3])); return 0.f; }
};
__device__ __forceinline__ void st16_sc1(float* p, f32x4 v) { asm volatile("global_store_dwordx4 %0, %1, off sc1\n\ts_nop 1" :: "v"(p), "v"(v) : "memory"); }
struct EpiRes {
    static constexpr bool MIDK = false, ROWSS = NEED_HSB, P16 = false; static constexpr int EB = 2;
    float* hs; bf16_t* hsb; float* rsp; int dry; unsigned char* hsb8; float sc; const float* res;
    __device__ __forceinline__ float row_scale(int, int) const { return 1.f; }
    __device__ __forceinline__ Col col(int, int) const { Col c; c.c0 = (f32x4){0.f, 0.f, 0.f, 0.f}; c.c1 = c.c0; return c; }
    __device__ __forceinline__ Side side(int row, int cb, int fq, int) const { Side s; s.a = *(const f32x4*)(res + (size_t)row * D + cb + 4 * fq); s.b = *(const f32x4*)(res + (size_t)row * D + cb + 16 + 4 * fq); return s; }
    __device__ __forceinline__ float one(int row, int c, f32x4 v, f32x4 old) const {
        float s_ = sc; asm volatile("" : "+v"(s_));
        const f32x4 h = old + v * s_; if (!dry) { if (FUSE_POST) st16_sc1(hs + (size_t)row * D + c, h); else *(f32x4*)(hs + (size_t)row * D + c) = h; if (NEED_HSB) st4bf(hsb + (size_t)row * D + c, h); if (hsb8) *(unsigned*)(hsb8 + (size_t)row * D + c) = pk4f8(h[0], h[1], h[2], h[3]); }
        return h[0] * h[0] + h[1] * h[1] + h[2] * h[2] + h[3] * h[3];
    }
    __device__ __forceinline__ float store(int row, float, int cb, int fq, f32x4 v0, f32x4 v1, const Side& s, const Col&) const { return one(row, cb + 4 * fq, v0, s.a) + one(row, cb + 16 + 4 * fq, v1, s.b); }
    __device__ __forceinline__ void write_ss(int row, int pidx, float ss) const { if (!dry) rsp[(size_t)row * 16 + pidx] = ss; }
};
struct EpiUp {
    static constexpr bool MIDK = false, ROWSS = false, P16 = PERM16; static constexpr int EB = 2;
    const float* rsp; unsigned char* act; int dry; int f8;
    __device__ __forceinline__ Col16 col16(int, int, int) const { Col16 c; c.b[0] = (f32x4){0.f, 0.f, 0.f, 0.f}; c.b[1] = c.b[0]; c.b[2] = c.b[0]; c.b[3] = c.b[0]; return c; }
    __device__ __forceinline__ f32x4 sw4(float rs, f32x4 g, f32x4 u) const { f32x4 o; o[0] = silu_(rs * g[0]) * (rs * u[0]); o[1] = silu_(rs * g[1]) * (rs * u[1]); o[2] = silu_(rs * g[2]) * (rs * u[2]); o[3] = silu_(rs * g[3]) * (rs * u[3]); return o; }
    __device__ __forceinline__ void store16(int row, float rs, int pn, int wc, int fq, f32x4 v00, f32x4 v01, f32x4 v10, f32x4 v11, const Col16&) const {
        if (dry) { asm volatile("" :: "v"(v00), "v"(v01), "v"(v10), "v"(v11)); return; }
        const f32x4 o0 = sw4(rs, v00, v01), o1 = sw4(rs, v10, v11);
        const size_t a0 = (size_t)row * DFF + pn * 128 + wc * 32 + fq * 8;
        if (f8) { u32x2 o; o[0] = pk4f8(o0[0], o0[1], o0[2], o0[3]); o[1] = pk4f8(o1[0], o1[1], o1[2], o1[3]); *(u32x2*)(act + a0) = o; } else st8bf((bf16_t*)act + a0, o0, o1);
    }
    __device__ __forceinline__ void rider_pair(int row, float rs, int pn, int bj, int wc, int fq, f32x4 v0, f32x4 v1) const {
        const f32x4 o = sw4(rs, v0, v1);
        const size_t a0 = (size_t)row * DFF + pn * 128 + wc * 32 + fq * 8 + bj * 4;
        if (f8) *(unsigned*)(act + a0) = pk4f8(o[0], o[1], o[2], o[3]); else st4bf((bf16_t*)act + a0, o);
    }
    __device__ __forceinline__ float row_scale(int row, int) const { return (dry || UMM == 3) ? 1.f : rinv_from_partials(rsp, row) * (UMM == 1 ? FSC : 1.0f); }
    __device__ __forceinline__ Col col(int, int) const { Col c; c.c0 = (f32x4){0.f, 0.f, 0.f, 0.f}; c.c1 = c.c0; return c; }
    __device__ __forceinline__ Side side(int, int, int, int) const { Side s; s.a = (f32x4){0.f, 0.f, 0.f, 0.f}; s.b = s.a; return s; }
    __device__ __forceinline__ float store(int row, float rs, int cb, int fq, f32x4 v0, f32x4 v1, const Side&, const Col&) const {
        if (dry) { asm volatile("" :: "v"(v0), "v"(v1)); return 0.f; }
        f32x4 o; o[0] = silu_(rs * v0[0]) * (rs * v1[0]); o[1] = silu_(rs * v0[1]) * (rs * v1[1]); o[2] = silu_(rs * v0[2]) * (rs * v1[2]); o[3] = silu_(rs * v0[3]) * (rs * v1[3]);
        if (f8) *(unsigned*)(act + (size_t)row * DFF + (cb >> 1) + 4 * fq) = pk4f8(o[0], o[1], o[2], o[3]); else st4bf((bf16_t*)act + (size_t)row * DFF + (cb >> 1) + 4 * fq, o);
        return 0.f;
    }
};
struct EpiMoeUp {
    static constexpr bool MIDK = false, ROWSS = false, P16 = PERM16; static constexpr int EB = 2;
    unsigned char* act;
    __device__ __forceinline__ Col16 col16(int, int, int) const { Col16 c; c.b[0] = (f32x4){0.f, 0.f, 0.f, 0.f}; c.b[1] = c.b[0]; c.b[2] = c.b[0]; c.b[3] = c.b[0]; return c; }
    __device__ __forceinline__ f32x4 sw4(float rs, f32x4 g, f32x4 u) const { f32x4 o; o[0] = silu_(rs * g[0]) * (rs * u[0]); o[1] = silu_(rs * g[1]) * (rs * u[1]); o[2] = silu_(rs * g[2]) * (rs * u[2]); o[3] = silu_(rs * g[3]) * (rs * u[3]); return o; }
    __device__ __forceinline__ void store16(int row, float rs, int pn, int wc, int fq, f32x4 v00, f32x4 v01, f32x4 v10, f32x4 v11, const Col16&) const {
        const f32x4 o0 = sw4(rs, v00, v01), o1 = sw4(rs, v10, v11);
        const size_t a0 = (size_t)row * EFF + pn * 128 + wc * 32 + fq * 8;
        if constexpr (DESZ_M == 1) { u32x2 o; o[0] = pk4f8(o0[0], o0[1], o0[2], o0[3]); o[1] = pk4f8(o1[0], o1[1], o1[2], o1[3]); *(u32x2*)(act + a0) = o; } else st8bf((bf16_t*)act + a0, o0, o1);
    }
    __device__ __forceinline__ float row_scale(int, int) const { return 1.f; }
    __device__ __forceinline__ Col col(int, int) const { Col c; c.c0 = (f32x4){0.f, 0.f, 0.f, 0.f}; c.c1 = c.c0; return c; }
    __device__ __forceinline__ Side side(int, int, int, int) const { Side s; s.a = (f32x4){0.f, 0.f, 0.f, 0.f}; s.b = s.a; return s; }
    __device__ __forceinline__ float store(int row, float rs, int cb, int fq, f32x4 v0, f32x4 v1, const Side&, const Col&) const {
        const float s = rs * (UMM == 1 ? FSC : 1.0f);
        f32x4 o; o[0] = silu_(s * v0[0]) * (s * v1[0]); o[1] = silu_(s * v0[1]) * (s * v1[1]); o[2] = silu_(s * v0[2]) * (s * v1[2]); o[3] = silu_(s * v0[3]) * (s * v1[3]);
        if constexpr (DESZ_M == 1) *(unsigned*)(act + (size_t)row * EFF + (cb >> 1) + 4 * fq) = pk4f8(o[0], o[1], o[2], o[3]); else st4bf((bf16_t*)act + (size_t)row * EFF + (cb >> 1) + 4 * fq, o);
        return 0.f;
    }
};
struct EpiMoeDown {
    static constexpr bool MIDK = false, ROWSS = false, P16 = false; static constexpr int EB = 2;
    const float* sgate; bf16_t* ys;
    __device__ __forceinline__ float row_scale(int row, int) const { return sgate[row] * (DESZ_M == 1 ? FSC : 1.0f); }
    __device__ __forceinline__ Col col(int, int) const { Col c; c.c0 = (f32x4){0.f, 0.f, 0.f, 0.f}; c.c1 = c.c0; return c; }
    __device__ __forceinline__ Side side(int, int, int, int) const { Side s; s.a = (f32x4){0.f, 0.f, 0.f, 0.f}; s.b = s.a; return s; }
    __device__ __forceinline__ float store(int row, float rs, int cb, int fq, f32x4 v0, f32x4 v1, const Side&, const Col&) const {
        st4bf(ys + (size_t)row * D + cb + 4 * fq, v0 * rs); st4bf(ys + (size_t)row * D + cb + 16 + 4 * fq, v1 * rs); return 0.f;
    }
};

typedef int i32x4 __attribute__((ext_vector_type(4)));
typedef int i32x8 __attribute__((ext_vector_type(8)));
#define CAT8(x, y) __builtin_shufflevector((i32x4)(x), (i32x4)(y), 0, 1, 2, 3, 4, 5, 6, 7)
__device__ __forceinline__ void glds16(unsigned voff, const char* base, unsigned ldsaddr) {
    unsigned keep;
    asm volatile("s_mov_b32 %0, m0\n\ts_mov_b32 m0, %3\n\ts_nop 0\n\tglobal_load_lds_dwordx4 %1, %2\n\ts_mov_b32 m0, %0" : "=&s"(keep) : "v"(voff), "s"(base), "s"(ldsaddr) : "memory");
}
namespace pg8 {
constexpr int BM = 256, BK = 64, HALF = 128, HTB = HALF * BK * 2, STAGE_BYTES = 8 * HTB, NXCD = 8, WGM = 8;
__host__ __device__ __forceinline__ int lds_byte(int r, int c) { const int st = (r >> 4) * 2 + (c >> 5), rr = r & 15, cc = c & 31, ob = rr * 64 + cc * 2; return st * 1024 + (ob ^ (((ob >> 9) & 1) << 5)); }
__host__ __device__ __forceinline__ void stage_rc(int b, int& R, int& C) { const int st = b / 1024, sb = b % 1024, swz = sb ^ (((sb >> 9) & 1) << 5); R = (st >> 1) * 16 + swz / 64; C = (st & 1) * 32 + (swz % 64) / 2; }
struct Unit { int pm, pn, aux; const char* A; const char* B; const float* SB; };

struct DenseOrder {
    const char* A; const char* B; const float* SB; int nM, nN, nwg, G, c, pn0; size_t tstep;
    __device__ __forceinline__ void init(const void* A_, const void* B_, int M, int N, int K, int esz, int G_, int c_, int pn0_ = 0) { pn0 = pn0_; SB = nullptr; A = (const char*)A_; B = (const char*)B_; nM = M / BM; nN = N / BM; nwg = nM * nN; G = G_; c = c_; tstep = (size_t)BM * K * esz; }
    __device__ __forceinline__ bool next(int i, Unit& u) const {
        const long L = (long)i * G + c; if (L >= nwg) return false;
        int wgid = (int)L; { const int q = nwg / NXCD, r = nwg % NXCD, xcd = wgid % NXCD, off = wgid / NXCD; wgid = (xcd < r ? xcd * (q + 1) : r * (q + 1) + (xcd - r) * q) + off; }
        const int nig = WGM * nN, gid = wgid / nig, fm = gid * WGM, gsz = (nM - fm) < WGM ? (nM - fm) : WGM;
        u.pm = fm + ((wgid % nig) % gsz); u.pn = pn0 + (wgid % nig) / gsz; u.aux = 0; u.A = A + (size_t)u.pm * tstep; u.B = B + (size_t)u.pn * tstep; u.SB = SB ? SB + u.pn * BM : nullptr; return true;
    }
    __device__ __forceinline__ int arow(const Unit&, int r) const { return r; }
};
constexpr bool GROUPED_XCD = true;
struct GroupedOrder {
    const char* A; const char* B; const int* texp; const int* idx; size_t estride, tstepA, tstepB; int nM, nN, nwg, G, c; const float* SB; int sbstride;
    __device__ __forceinline__ bool next(int i, Unit& u) const {
        const long L = (long)i * G + c; if (L >= nwg) return false;
        int wgid = (int)L;
        if (GROUPED_XCD) { const int q = nwg / NXCD, r = nwg % NXCD, xcd = wgid % NXCD, off = wgid / NXCD; wgid = (xcd < r ? xcd * (q + 1) : r * (q + 1) + (xcd - r) * q) + off; }
        u.pm = __builtin_amdgcn_readfirstlane(wgid / nN); u.pn = __builtin_amdgcn_readfirstlane(wgid % nN); u.aux = 0;
        const int ex = __builtin_amdgcn_readfirstlane(texp[u.pm]);
        u.A = A + (size_t)u.pm * tstepA; u.B = B + (size_t)ex * estride + (size_t)u.pn * tstepB; u.SB = SB ? SB + ex * sbstride + u.pn * BM : nullptr; return true;
    }
    __device__ __forceinline__ int arow(const Unit& u, int r) const { return idx[u.pm * BM + r]; }
};

template <class Epi, class Sched, int MM>
__device__ __forceinline__ void gemm_phase(LAS unsigned char* lds, const int K, const int lda, const int ldb, const Sched& S, const Epi& E, int tid, const float* SA = nullptr) {
    constexpr int ESZ = (MM == 2) ? 2 : 1;
    const int wid = __builtin_amdgcn_readfirstlane(tid >> 6), lane = tid & 63, wr = wid >> 2, wc = wid & 3, fr = lane & 15, fq = lane >> 4;
    const int nt = (K * ESZ) / 128;
    unsigned voffB[2], voffA[2];
#pragma unroll
    for (int i = 0; i < 2; ++i) { int sR, sC; stage_rc(tid * 16 + i * 8192, sR, sC); voffB[i] = (unsigned)(sR * ldb * ESZ + sC * 2); voffA[i] = (unsigned)(sR * lda * ESZ + sC * 2); }
    const size_t hstepA = (size_t)HALF * lda * ESZ;
    const size_t kstep = (size_t)(BK * 2);
    const size_t hstep = (size_t)HALF * ldb * ESZ;
    const unsigned ldsw = (unsigned)wid * 1024u;
    const unsigned ldsbase = (unsigned)__builtin_amdgcn_readfirstlane((int)(unsigned)(size_t)lds) + ldsw;
    const int aoff = lds_byte(wr * 64 + fr, fq * 8), boff = lds_byte(wc * 32 + fr, fq * 8);
#define PG8_SA(b, h) (((b) * 2 + (h)) * HTB)
#define PG8_SB(b, h) ((4 + (b) * 2 + (h)) * HTB)
#define PG8_STAGE(bufoff, gbase, voff) do { _Pragma("unroll") for (int _i = 0; _i < 2; ++_i) \
        glds16((voff)[_i], (const char*)(gbase), ldsbase + (unsigned)((bufoff) + _i * 8192)); } while (0)
#define PG8_LDA(dst, b, h) do { _Pragma("unroll") for (int m = 0; m < 4; ++m) { dst[m].lo = *(const LAS i32x4*)(lds + PG8_SA(b, h) + aoff + m * 2048); dst[m].hi = *(const LAS i32x4*)(lds + PG8_SA(b, h) + aoff + m * 2048 + 1024); } } while (0)
#define PG8_LDB(dst, b, h) do { _Pragma("unroll") for (int n = 0; n < 2; ++n) { dst[n].lo = *(const LAS i32x4*)(lds + PG8_SB(b, h) + boff + n * 2048); dst[n].hi = *(const LAS i32x4*)(lds + PG8_SB(b, h) + boff + n * 2048 + 1024); } } while (0)
#define PG8_MMA(ai, bj, At, Bt) do { __builtin_amdgcn_s_setprio(1); _Pragma("unroll") for (int m = 0; m < 4; ++m) _Pragma("unroll") for (int n = 0; n < 2; ++n) { \
        if constexpr (ESZ == 2) { acc[ai][bj][m][n] = __builtin_amdgcn_mfma_f32_16x16x32_bf16((bf16x8)Bt[n].lo, (bf16x8)At[m].lo, acc[ai][bj][m][n], 0, 0, 0); \
                                  acc[ai][bj][m][n] = __builtin_amdgcn_mfma_f32_16x16x32_bf16((bf16x8)Bt[n].hi, (bf16x8)At[m].hi, acc[ai][bj][m][n], 0, 0, 0); } \
        else if constexpr (MM == 3) { acc[ai][bj][m][n] = (f32x4)__builtin_amdgcn_mfma_i32_16x16x64_i8(Bt[n].lo, At[m].lo, (i32x4)acc[ai][bj][m][n], 0, 0, 0); \
                                      acc[ai][bj][m][n] = (f32x4)__builtin_amdgcn_mfma_i32_16x16x64_i8(Bt[n].hi, At[m].hi, (i32x4)acc[ai][bj][m][n], 0, 0, 0); } \
        else acc[ai][bj][m][n] = __builtin_amdgcn_mfma_scale_f32_16x16x128_f8f6f4(Bt[n], At[m], acc[ai][bj][m][n], 0, 0, 0, 0, 0, 0); } \
        __builtin_amdgcn_s_setprio(0); } while (0)
#define PG8_WAIT_V(n) asm volatile("s_waitcnt vmcnt(" #n ")" ::: "memory")
#define PG8_WAIT_L(n) asm volatile("s_waitcnt lgkmcnt(" #n ")" ::: "memory")
#define PG8_BAR __builtin_amdgcn_s_barrier()
#define PG8_SCHED __builtin_amdgcn_sched_barrier(0)
    Unit cur, nxt; int ui = 0;
    if (!S.next(0, cur)) return;
    f32x4 acc[2][2][4][2];
#define PG8_ZERO_ACC() do { _Pragma("unroll") for (int a = 0; a < 2; ++a) _Pragma("unroll") for (int b = 0; b < 2; ++b) _Pragma("unroll") for (int m = 0; m < 4; ++m) _Pragma("unroll") for (int n = 0; n < 2; ++n) { \
        float z0, z1, z2, z3; asm volatile("v_mov_b32 %0, 0\n\tv_mov_b32 %1, 0\n\tv_mov_b32 %2, 0\n\tv_mov_b32 %3, 0" : "=v"(z0), "=v"(z1), "=v"(z2), "=v"(z3)); \
        acc[a][b][m][n] = (f32x4){z0, z1, z2, z3}; } } while (0)
    PG8_ZERO_ACC();
    i32x8 At[4], B0[2], B1[2];
    const char* cA = cur.A; const char* cB = cur.B;
    PG8_STAGE(PG8_SB(0, 0), cB, voffB); PG8_STAGE(PG8_SB(0, 1), cB + hstep, voffB); PG8_STAGE(PG8_SA(0, 0), cA, voffA); PG8_STAGE(PG8_SA(0, 1), cA + hstepA, voffA);
    if (wr == 1) PG8_BAR;
    PG8_WAIT_V(2); PG8_BAR;
    PG8_STAGE(PG8_SB(1, 0), cB + kstep, voffB); PG8_STAGE(PG8_SA(1, 0), cA + kstep, voffA); PG8_STAGE(PG8_SB(1, 1), cB + hstep + kstep, voffB);
    PG8_WAIT_V(6); PG8_BAR;
    for (;;) {
        const bool has_next = S.next(ui + 1, nxt);
        const char* nA = has_next ? nxt.A : cA; const char* nB = has_next ? nxt.B : cB;
#define PG8_KITER(t, last) do { \
            const char* a1 = cA + (size_t)((t) + 1) * kstep; \
            const char* a2 = (last) ? nA : cA + (size_t)((t) + 2) * kstep; const char* b2 = (last) ? nB : cB + (size_t)((t) + 2) * kstep; \
            const char* a3 = a2 + kstep; const char* b3 = b2 + kstep; \
            PG8_LDB(B0, 0, 0); PG8_LDB(B1, 0, 1); PG8_SCHED; PG8_LDA(At, 0, 0); PG8_STAGE(PG8_SA(1, 1), a1 + hstepA, voffA); \
            PG8_WAIT_V(8); PG8_WAIT_L(0); PG8_BAR; PG8_MMA(0, 0, At, B0); PG8_MMA(0, 1, At, B1); PG8_BAR; PG8_SCHED; \
            PG8_LDA(At, 0, 1); PG8_STAGE(PG8_SB(0, 0), b2, voffB); PG8_STAGE(PG8_SB(0, 1), b2 + hstep, voffB); PG8_STAGE(PG8_SA(0, 0), a2, voffA); \
            PG8_WAIT_V(8); PG8_WAIT_L(0); PG8_BAR; PG8_MMA(1, 0, At, B0); PG8_MMA(1, 1, At, B1); PG8_BAR; PG8_SCHED; \
            PG8_LDB(B0, 1, 0); PG8_LDB(B1, 1, 1); PG8_SCHED; PG8_LDA(At, 1, 0); PG8_STAGE(PG8_SA(0, 1), a2 + hstepA, voffA); \
            PG8_WAIT_V(8); PG8_WAIT_L(0); PG8_BAR; PG8_MMA(0, 0, At, B0); PG8_MMA(0, 1, At, B1); PG8_BAR; PG8_SCHED; \
            PG8_LDA(At, 1, 1); PG8_STAGE(PG8_SB(1, 0), b3, voffB); PG8_STAGE(PG8_SB(1, 1), b3 + hstep, voffB); PG8_STAGE(PG8_SA(1, 0), a3, voffA); \
            PG8_WAIT_V(8); PG8_WAIT_L(0); PG8_BAR; PG8_MMA(1, 0, At, B0); PG8_MMA(1, 1, At, B1); PG8_BAR; PG8_SCHED; \
        } while (0)
#pragma clang loop unroll(disable)
        for (int t = 0; t < nt; t += 2) {
            if constexpr (Epi::MIDK) {
                if (t == nt / 2) {
#pragma unroll
                    for (int ai = 0; ai < 2; ++ai)
#pragma unroll
                        for (int m = 0; m < 4; ++m) {
                            E.mid16(cur.pm * BM + ai * HALF + wr * 64 + m * 16 + fr, cur.pn, wc, fq, acc[ai][0][m][0], acc[ai][0][m][1], acc[ai][1][m][0], acc[ai][1][m][1]);
                            asm volatile("" ::: "memory");
                        }
                }
            }
            const bool last = (t == nt - 2); PG8_KITER(t, last);
        }
        if (wr == 0) PG8_BAR;
        {
            int epm = cur.pm, epn = cur.pn, eaux = cur.aux, et = wid * 64 + lane_id_now();
            asm volatile("" : "+s"(epm), "+s"(epn), "+s"(eaux), "+v"(et));
            const int elane = et & 63, fr = elane & 15, fq = elane >> 4, ewid = __builtin_amdgcn_readfirstlane(et >> 6), wr = ewid >> 2, wc = ewid & 3;
            Col cl[2];
#pragma unroll
            for (int bj = 0; bj < 2; ++bj) cl[bj] = E.col(epn * BM + bj * HALF + wc * 32, fq);
            f32x4 sb[2][2];
            if constexpr (MM == 3) {
#pragma unroll
                for (int bj = 0; bj < 2; ++bj)
#pragma unroll
                    for (int n = 0; n < 2; ++n) sb[bj][n] = *(const f32x4*)(cur.SB + bj * HALF + wc * 32 + n * 16 + 4 * fq) * (1.0f / 127.0f);
            }
            if constexpr (Epi::P16) {
                const Col16 c16 = E.col16(epn, wc, fq);
#pragma unroll
                for (int ai = 0; ai < 2; ++ai)
#pragma unroll
                    for (int mb = 0; mb < 4; mb += 2) {
                        float rsv[4];
#pragma unroll
                        for (int m = mb; m < mb + 2; ++m) { const int row = epm * BM + ai * HALF + wr * 64 + m * 16 + fr; rsv[m] = E.row_scale(row, eaux); if constexpr (MM == 3) rsv[m] *= SA[row]; }
#pragma unroll
                        for (int m = mb; m < mb + 2; ++m) {
                            const int row = epm * BM + ai * HALF + wr * 64 + m * 16 + fr;
                            f32x4 v[2][2];
#pragma unroll
                            for (int bj = 0; bj < 2; ++bj)
#pragma unroll
                                for (int n = 0; n < 2; ++n) {
                                    v[bj][n] = acc[ai][bj][m][n];
                                    if constexpr (MM == 3) { const i32x4 iv = (i32x4)v[bj][n]; v[bj][n][0] = (float)iv[0] * sb[bj][n][0]; v[bj][n][1] = (float)iv[1] * sb[bj][n][1]; v[bj][n][2] = (float)iv[2] * sb[bj][n][2]; v[bj][n][3] = (float)iv[3] * sb[bj][n][3]; }
                                }
                            E.store16(row, rsv[m], epn, wc, fq, v[0][0], v[0][1], v[1][0], v[1][1], c16);
                            asm volatile("" ::: "memory");
                        }
                    }
            } else {
#pragma unroll
            for (int ai = 0; ai < 2; ++ai) {
#pragma unroll
              for (int mb = 0; mb < 4; mb += Epi::EB) {
                float rsv[4]; Side sd[4][2];
#pragma unroll
                for (int m = mb; m < mb + Epi::EB; ++m) {
                    const int row = epm * BM + ai * HALF + wr * 64 + m * 16 + fr;
                    rsv[m] = E.row_scale(row, eaux);
                    if constexpr (MM == 3) rsv[m] *= SA[row];
#pragma unroll
                    for (int bj = 0; bj < 2; ++bj) sd[m][bj] = E.side(row, epn * BM + bj * HALF + wc * 32, fq, eaux);
                }
#pragma unroll
                for (int m = mb; m < mb + Epi::EB; ++m) {
                    const int row = epm * BM + ai * HALF + wr * 64 + m * 16 + fr;
                    float ss = 0.f;
#pragma unroll
                    for (int bj = 0; bj < 2; ++bj) {
                        f32x4 v0 = acc[ai][bj][m][0], v1 = acc[ai][bj][m][1];
                        if constexpr (MM == 3) {
                            const i32x4 i0 = (i32x4)v0, i1 = (i32x4)v1;
                            v0[0] = (float)i0[0] * sb[bj][0][0]; v0[1] = (float)i0[1] * sb[bj][0][1]; v0[2] = (float)i0[2] * sb[bj][0][2]; v0[3] = (float)i0[3] * sb[bj][0][3];
                            v1[0] = (float)i1[0] * sb[bj][1][0]; v1[1] = (float)i1[1] * sb[bj][1][1]; v1[2] = (float)i1[2] * sb[bj][1][2]; v1[3] = (float)i1[3] * sb[bj][1][3];
                        }
                        ss += E.store(row, rsv[m], epn * BM + bj * HALF + wc * 32, fq, v0, v1, sd[m][bj], cl[bj]);
                    }
                    if constexpr (Epi::ROWSS) {
                        ss += shflx(ss, elane, 16); ss += shflx(ss, elane, 32);
                        if (fq == 0) E.write_ss(row, epn * 4 + wc, ss);
                    }
                    asm volatile("" ::: "memory");
                }
              }
            }
            }
        }
        if (!has_next) break;
        PG8_ZERO_ACC();
        cur = nxt; cA = nA; cB = nB; ++ui;
        if (wr == 1) PG8_BAR;
    }
    PG8_WAIT_V(0);
    PG8_BAR;
#undef PG8_SA
#undef PG8_SB
#undef PG8_STAGE
#undef PG8_LDA
#undef PG8_LDB
#undef PG8_MMA
#undef PG8_WAIT_V
#undef PG8_WAIT_L
#undef PG8_BAR
#undef PG8_SCHED
#undef PG8_KITER
#undef PG8_ZERO_ACC
}
}


template <class Epi, bool PROJ, int MM>
__device__ __forceinline__ void rider_gemm(const Frame& F, const bf16_t* A, int lda, const bf16_t* Bt, int N, int K, const Epi& E, const bf16_t* gates, bf16_t* yout, const float* SA = nullptr, const float* SB = nullptr, int ulo = 0, int uhi = -1, int rank = -1) {
    constexpr int ESZ = (MM == 2) ? 2 : 1;
    const int lane = F.lane, fr = lane & 15, fq = lane >> 4, w = F.wave;
    LAS f32x4* red = (LAS f32x4*)F.lds;
    const int kwb = (K * ESZ) >> 3;
    for (int u = ulo + (rank < 0 ? F.nblk - 1 - F.blk : rank); u < (uhi < 0 ? (N >> 6) : uhi); u += F.nblk) {
        const int n0 = u * 64;
        const char* ap = (const char*)A + (size_t)(NTOK + fr) * lda * ESZ + w * kwb + 16 * fq;
        const char* bp = (const char*)Bt + (size_t)(n0 + fr) * K * ESZ + w * kwb + 16 * fq;
        f32x4 acc[4];
#pragma unroll
        for (int ni = 0; ni < 4; ++ni) acc[ni] = zero4();
        for (int kb = 0; kb < kwb; kb += 128) {
            i32x8 af, bf[4];
            af.lo = *(const i32x4*)(ap + kb); af.hi = *(const i32x4*)(ap + kb + 64);
#pragma unroll
            for (int ni = 0; ni < 4; ++ni) { bf[ni].lo = *(const i32x4*)(bp + (size_t)(16 * ni) * K * ESZ + kb); bf[ni].hi = *(const i32x4*)(bp + (size_t)(16 * ni) * K * ESZ + kb + 64); }
#pragma unroll
            for (int ni = 0; ni < 4; ++ni) {
                if constexpr (MM == 2) {
                    acc[ni] = __builtin_amdgcn_mfma_f32_16x16x32_bf16((bf16x8)bf[ni].lo, (bf16x8)af.lo, acc[ni], 0, 0, 0);
                    acc[ni] = __builtin_amdgcn_mfma_f32_16x16x32_bf16((bf16x8)bf[ni].hi, (bf16x8)af.hi, acc[ni], 0, 0, 0);
                } else if constexpr (MM == 3) {
                    acc[ni] = (f32x4)__builtin_amdgcn_mfma_i32_16x16x64_i8(bf[ni].lo, af.lo, (i32x4)acc[ni], 0, 0, 0);
                    acc[ni] = (f32x4)__builtin_amdgcn_mfma_i32_16x16x64_i8(bf[ni].hi, af.hi, (i32x4)acc[ni], 0, 0, 0);
                } else acc[ni] = __builtin_amdgcn_mfma_scale_f32_16x16x128_f8f6f4(bf[ni], af, acc[ni], 0, 0, 0, 0, 0, 0);
            }
        }
        if constexpr (MM == 3) {
#pragma unroll
            for (int ni = 0; ni < 4; ++ni) { const i32x4 iv = (i32x4)acc[ni]; acc[ni][0] = (float)iv[0]; acc[ni][1] = (float)iv[1]; acc[ni][2] = (float)iv[2]; acc[ni][3] = (float)iv[3]; }
        }
        __syncthreads();
#pragma unroll
        for (int ni = 0; ni < 4; ++ni) red[(w * 4 + ni) * 64 + lane] = acc[ni];
        __syncthreads();
        if (w == 0) {
            const int row = NTOK + fr;
            float ss = 0.f;
#pragma unroll
            for (int q = 0; q < 2; ++q) {
                f32x4 v0a = zero4(), v1a = v0a, v0b = v0a, v1b = v0a;
#pragma unroll
                for (int x = 0; x < 4; ++x) { v0a += red[(x * 4 + 2 * q) * 64 + lane]; v1a += red[(x * 4 + 2 * q + 1) * 64 + lane]; v0b += red[((x + 4) * 4 + 2 * q) * 64 + lane]; v1b += red[((x + 4) * 4 + 2 * q + 1) * 64 + lane]; }
                const int cb = n0 + 32 * q;
                if constexpr (PROJ) {
                    const int col0 = (cb >> 8) * 256 + ((cb >> 5) & 3) * 64 + fq * 16 + ((cb >> 7) & 1) * 8;
                    const bf16_t* gp = gates + (size_t)row * 2048 + col0;
                    f32x4 g00, g01, g10, g11;
                    if (GATES8) { const unsigned char* g8 = (const unsigned char*)gates + (size_t)row * 2048 + col0; const u32x2 a = *(const u32x2*)g8, b = *(const u32x2*)(g8 + 1024);
                        g00 = un4u8(a[0]) * (1.0f / 255.0f); g01 = un4u8(a[1]) * (1.0f / 255.0f); g10 = un4u8(b[0]) * (1.0f / 255.0f); g11 = un4u8(b[1]) * (1.0f / 255.0f); }
                    else { g00 = ld4bf(gp); g01 = ld4bf(gp + 4); g10 = ld4bf(gp + 1024); g11 = ld4bf(gp + 1024 + 4); }
                    const f32x4 y0 = g00 * v0a + g10 * v0b, y1 = g01 * v1a + g11 * v1b;
                    if (E.y8) { u32x2 o; o[0] = pk4f8(y0[0] * YSC, y0[1] * YSC, y0[2] * YSC, y0[3] * YSC); o[1] = pk4f8(y1[0] * YSC, y1[1] * YSC, y1[2] * YSC, y1[3] * YSC); *(u32x2*)((unsigned char*)yout + (size_t)row * D + col0) = o; }
                    else st8bf(yout + (size_t)row * D + col0, y0, y1);
                } else {
                    float rs = E.row_scale(row, 0);
                    f32x4 w0 = v0a + v0b, w1 = v1a + v1b;
                    if constexpr (MM == 3) { rs *= SA[row]; w0 = w0 * (*(const f32x4*)(SB + cb + 4 * fq) * (1.0f / 127.0f)); w1 = w1 * (*(const f32x4*)(SB + cb + 16 + 4 * fq) * (1.0f / 127.0f)); }
                    if constexpr (Epi::P16) E.rider_pair(row, rs, cb >> 8, (cb >> 7) & 1, (cb >> 5) & 3, fq, w0, w1);
                    else { const Col cl = E.col(cb, fq); const Side sd = E.side(row, cb, fq, 0); ss += E.store(row, rs, cb, fq, w0, w1, sd, cl); }
                }
            }
            if constexpr (Epi::ROWSS) { ss += shflx(ss, lane, 16); ss += shflx(ss, lane, 32); if (fq == 0) E.write_ss(row, u, ss); }
        }
    }
}

template <class Epi, int MM = 2>
__device__ __forceinline__ void dense_gemm(const Frame& G, const void* A, const void* Bt, int N, int K, const Epi& E, const float* SA = nullptr, const float* SB = nullptr, const Epi* ER = nullptr, int nbody = -1, int ruhi = -1) {
    const Frame F = local_frame(G);
    pg8::DenseOrder S; S.init(A, Bt, NTOK, nbody < 0 ? N : nbody, K, (MM == 2) ? 2 : 1, F.nblk, F.blk); S.SB = SB;
    pg8::gemm_phase<Epi, pg8::DenseOrder, MM>(F.lds, K, K, K, S, E, F.tid, SA);
    const Frame R = local_frame(G);
    rider_gemm<Epi, false, MM>(R, (const bf16_t*)A, K, (const bf16_t*)Bt, N, K, ER ? *ER : E, nullptr, nullptr, SA, SB, 0, ruhi);
}


__device__ __forceinline__ void moe_router(const Frame& G, int layer, int c_lo, int c_hi);
__device__ __forceinline__ bool panel_arrive(const Frame& F, unsigned* cnt, unsigned expect, bool wait_all) {
    LAS unsigned* w = (LAS unsigned*)(F.lds + LDS_MISC_OFF + 32);
    asm volatile("s_waitcnt vmcnt(0)" ::: "memory");
    __syncthreads();
    if (F.tid == 0) {
        const unsigned old = __hip_atomic_fetch_add(cnt, 1u, __ATOMIC_RELAXED, __HIP_MEMORY_SCOPE_AGENT);
        bool done = (old + 1u == expect);
        if (wait_all && !done) {
            unsigned sp = 0;
            while (__hip_atomic_load(cnt, __ATOMIC_RELAXED, __HIP_MEMORY_SCOPE_AGENT) < expect) { __builtin_amdgcn_s_sleep(2); if (++sp > (1u << 20)) break; }
            done = true;
        }
        if (done) { __builtin_amdgcn_fence(__ATOMIC_ACQUIRE, "agent"); asm volatile("s_waitcnt vmcnt(0)" ::: "memory"); }
        *w = done ? 1u : 0u;
    }
    __syncthreads();
    const bool r = (*w != 0u);
    __syncthreads();
    return r;
}
template <int MM, int POST>
__device__ __forceinline__ void res_gemm(const Frame& G, const void* A, const void* Bt, int K, const EpiRes& E, int layer, unsigned* pcnt) {
    const Frame F = local_frame(G);
    pg8::DenseOrder S; S.init(A, Bt, NTOK, D, K, (MM == 2) ? 2 : 1, F.nblk, F.blk);
    pg8::gemm_phase<EpiRes, pg8::DenseOrder, MM>(F.lds, K, K, K, S, E, F.tid);
    if constexpr (POST != 0) {
        const Frame P = local_frame(G);
        pg8::DenseOrder S2; S2.init(A, Bt, NTOK, D, K, (MM == 2) ? 2 : 1, P.nblk, P.blk);
        for (int i = 0;; ++i) {
            pg8::Unit u; if (!S2.next(i, u)) break;
            if (panel_arrive(P, pcnt + u.pm * 16, 4u, true)) { const int r0 = u.pm * 256 + u.pn * 64; if (POST == 1) qnorm_rows(P, r0, r0 + 64); else moe_router(P, layer, u.pm * 4 + u.pn, u.pm * 4 + u.pn + 1); }
        }
    }
    const Frame R = local_frame(G);
    rider_gemm<EpiRes, false, MM>(R, (const bf16_t*)A, K, (const bf16_t*)Bt, D, K, E, nullptr, nullptr);
    if constexpr (POST != 0) {
        const Frame P = local_frame(G);
        for (int u = P.nblk - 1 - P.blk; u < (D >> 6); u += P.nblk)
            if (panel_arrive(P, pcnt + 64 * 16, (unsigned)(D >> 6), false)) { if (POST == 1) qnorm_rows(P, NTOK, NV); else moe_router(P, layer, 256, 257); }
    }
}

struct ProjOrder {
    const char* A; const char* B; int G, c;
    __device__ __forceinline__ bool next(int i, pg8::Unit& u) const {
        const int tile = c + (i >> 1) * G; if (tile >= 256) return false;
        u.pm = tile >> 2; u.pn = tile & 3; u.aux = i & 1; u.SB = nullptr;
        u.A = A + (size_t)u.pm * 256 * D * 2 + (size_t)u.aux * 512 * 2; u.B = B + (size_t)u.pn * 256 * D * 2 + (size_t)u.aux * 512 * 2; return true;
    }
    __device__ __forceinline__ int arow(const pg8::Unit&, int r) const { return r; }
};
struct EpiProj2 {
    static constexpr bool MIDK = false, ROWSS = false, P16 = false; static constexpr int EB = 2;
    const bf16_t* gates; bf16_t* y; int y8;
    __device__ __forceinline__ float row_scale(int, int aux) const { return aux ? 1.f : 0.f; }
    __device__ __forceinline__ Col col(int, int) const { Col c; c.c0 = (f32x4){0.f, 0.f, 0.f, 0.f}; c.c1 = c.c0; return c; }
    __device__ __forceinline__ Side side(int row, int cb, int fq, int aux) const {
        const bf16_t* gp = gates + (size_t)row * 2048 + aux * 1024 + cb + 4 * fq;
        Side s; s.a = bits4(*(const u32x2*)gp, *(const u32x2*)(gp + 16));
        if (aux) { const bf16_t* yp = y + (size_t)row * D + cb + 4 * fq; s.b = bits4(*(const u32x2*)yp, *(const u32x2*)(yp + 16)); } else s.b = (f32x4){0.f, 0.f, 0.f, 0.f};
        return s;
    }
    __device__ __forceinline__ float store(int row, float, int cb, int fq, f32x4 v0, f32x4 v1, const Side& s, const Col&) const {
        bf16_t* yp = y + (size_t)row * D + cb + 4 * fq;
        st4bf(yp, unpk4(s.b[0], s.b[1]) + v0 * unpk4(s.a[0], s.a[1])); st4bf(yp + 16, unpk4(s.b[2], s.b[3]) + v1 * unpk4(s.a[2], s.a[3])); return 0.f;
    }
};
__device__ __forceinline__ void ld16bf(const bf16_t* p, f32x4 (&o)[4]) { const u32x4 a = *(const u32x4*)p, b = *(const u32x4*)(p + 8);
    o[0] = unpk4(__uint_as_float(a[0]), __uint_as_float(a[1])); o[1] = unpk4(__uint_as_float(a[2]), __uint_as_float(a[3])); o[2] = unpk4(__uint_as_float(b[0]), __uint_as_float(b[1])); o[3] = unpk4(__uint_as_float(b[2]), __uint_as_float(b[3])); }
struct EpiProj3 {
    static constexpr bool MIDK = true, ROWSS = false, P16 = true; static constexpr int EB = 2;
    const bf16_t* gates; bf16_t* y; int y8;
    __device__ __forceinline__ float row_scale(int, int) const { return 1.f; }
    __device__ __forceinline__ Col col(int, int) const { Col c; c.c0 = (f32x4){0.f, 0.f, 0.f, 0.f}; c.c1 = c.c0; return c; }
    __device__ __forceinline__ Side side(int, int, int, int) const { Side s; s.a = (f32x4){0.f, 0.f, 0.f, 0.f}; s.b = s.a; return s; }
    __device__ __forceinline__ float store(int, float, int, int, f32x4, f32x4, const Side&, const Col&) const { return 0.f; }
    __device__ __forceinline__ Col16 col16(int, int, int) const { Col16 c; c.b[0] = (f32x4){0.f, 0.f, 0.f, 0.f}; c.b[1] = c.b[0]; c.b[2] = c.b[0]; c.b[3] = c.b[0]; return c; }
    __device__ __forceinline__ void mid16(int row, int pn, int wc, int fq, f32x4& v00, f32x4& v01, f32x4& v10, f32x4& v11) const {
        const int col0 = pn * 256 + wc * 64 + fq * 16;
        f32x4 g0[4], g1[4];
        if (GATES8) { ld16u8((const unsigned char*)gates + (size_t)row * 2048 + col0, g0); ld16u8((const unsigned char*)gates + (size_t)row * 2048 + 1024 + col0, g1); }
        else { ld16bf(gates + (size_t)row * 2048 + col0, g0); ld16bf(gates + (size_t)row * 2048 + 1024 + col0, g1); }
#pragma unroll
        for (int i = 0; i < 4; ++i) { v00[i] *= g0[0][i] * __builtin_amdgcn_rcpf(g1[0][i]); v01[i] *= g0[1][i] * __builtin_amdgcn_rcpf(g1[1][i]); v10[i] *= g0[2][i] * __builtin_amdgcn_rcpf(g1[2][i]); v11[i] *= g0[3][i] * __builtin_amdgcn_rcpf(g1[3][i]); }
    }
    __device__ __forceinline__ void store16(int row, float, int pn, int wc, int fq, f32x4 v00, f32x4 v01, f32x4 v10, f32x4 v11, const Col16&) const {
        const int col0 = pn * 256 + wc * 64 + fq * 16;
        f32x4 g1[4];
        if (GATES8) { ld16u8((const unsigned char*)gates + (size_t)row * 2048 + 1024 + col0, g1); g1[0] = g1[0] * (1.0f / 255.0f); g1[1] = g1[1] * (1.0f / 255.0f); g1[2] = g1[2] * (1.0f / 255.0f); g1[3] = g1[3] * (1.0f / 255.0f); }
        else ld16bf(gates + (size_t)row * 2048 + 1024 + col0, g1);
        if (y8) {
            const f32x4 a = v00 * g1[0] * YSC, b = v01 * g1[1] * YSC, c = v10 * g1[2] * YSC, d = v11 * g1[3] * YSC;
            u32x4 o; o[0] = pk4f8(a[0], a[1], a[2], a[3]); o[1] = pk4f8(b[0], b[1], b[2], b[3]); o[2] = pk4f8(c[0], c[1], c[2], c[3]); o[3] = pk4f8(d[0], d[1], d[2], d[3]);
            *(u32x4*)((unsigned char*)y + (size_t)row * D + col0) = o;
            return;
        }
        bf16_t* p = y + (size_t)row * D + col0;
        st8bf(p, v00 * g1[0], v01 * g1[1]); st8bf(p + 8, v10 * g1[2], v11 * g1[3]);
    }
};
__device__ __forceinline__ void proj_gemm(const Frame& G, const bf16_t* A, const bf16_t* Bt, const bf16_t* gates, bf16_t* y, int y8) {
    const Frame F = local_frame(G);
    pg8::DenseOrder S; S.init(A, Bt, NTOK, D, D, 2, F.nblk, F.blk);
    EpiProj3 E3{gates, y, y8};
    pg8::gemm_phase<EpiProj3, pg8::DenseOrder, 2>(F.lds, D, D, D, S, E3, F.tid);
    const Frame R = local_frame(G);
    EpiProj2 E2{gates, y, y8};
    rider_gemm<EpiProj2, true, 2>(R, A, D, Bt, D, D, E2, gates, y);
}

constexpr int S5_TROW = 272;
constexpr int S5_TBYTES = 128 * S5_TROW;
constexpr int S5_SC_OFF = 3 * S5_TBYTES;
constexpr int S5_SC_BYTES = 16 * S5_TROW;

template <bool D0>
__device__ __forceinline__ void s5_wave(const Frame& F, int layer, int g, int panel) {
    const int lane = F.lane, fr = lane & 15, fq = lane >> 4;
    const int row0 = panel < 64 ? panel * 256 : NTOK, nsub = panel < 64 ? 32 : 2;
    LAS unsigned char* tb = F.lds;
    LAS unsigned char* sc = F.lds + S5_SC_OFF + F.wave * S5_SC_BYTES;
    const bf16_t* us5 = WSP(bf16_t, T_US5);
    f32x2* span = WSP(f32x2, WS_SPAN);
    const f32x2 w8 = WSP(f32x2, WS_W8)[((size_t)layer * NG + g) * 64 + lane];
    float sr = 0.f, si = 0.f;
    if (D0 && panel < 64) {
        const f32x2 w256 = WSP(f32x2, WS_W256)[((size_t)layer * NG + g) * 64 + lane];
        const f32x2 sm = span[((size_t)64 * NG + g) * 64 + lane];
        sr = sm[0]; si = sm[1];
        const int b0 = (panel >> 5) << 5;
        for (int qb = b0; qb < panel; qb += 8) {
            f32x2 x[8];
#pragma unroll
            for (int i = 0; i < 8; ++i) { const int q = (qb + i < panel) ? qb + i : panel - 1; x[i] = span[((size_t)q * NG + g) * 64 + lane]; }
#pragma unroll
            for (int i = 0; i < 8; ++i) {
                if (qb + i < panel) {
                    const float nr = w256[0] * sr - w256[1] * si + x[i][0];
                    const float ni = w256[0] * si + w256[1] * sr + x[i][1];
                    sr = nr; si = ni;
                }
            }
        }
    }
    const float* dsk = F.in[12] + (size_t)layer * S5W + g * 16 + 4 * fq;
    const f32x4 dv = *(const f32x4*)dsk;
    bf16x8 ufa[2][4];
#pragma unroll
    for (int nt = 0; nt < 2; ++nt)
#pragma unroll
        for (int ks = 0; ks < 4; ++ks) {
            const int sub = nt * 16 + fr;
            const int tok = row0 + sub * 8 + 2 * ks + (fq >> 1);
            ufa[nt][ks] = (sub < nsub) ? *(const bf16x8*)(us5 + (size_t)tok * 512 + g * 16 + (fq & 1) * 8) : (bf16x8){0, 0, 0, 0, 0, 0, 0, 0};
        }
#pragma unroll
    for (int nt = 0; nt < 2; ++nt) {
        if (nt * 16 >= nsub) break;
        const int sub = nt * 16 + fr; const bool valid = sub < nsub;
        bf16x8 uf[4];
#pragma unroll
        for (int ks = 0; ks < 4; ++ks) uf[ks] = ufa[nt][ks];
#pragma unroll
        for (int mt = 0; mt < 8; ++mt) {
            f32x4 xa = zero4();
#pragma unroll
            for (int ks = 0; ks < 4; ++ks) {
                const bf16x8 a = *(const LAS bf16x8*)(tb + (mt * 16 + fr) * S5_TROW + (ks * 32 + fq * 8) * 2);
                xa = __builtin_amdgcn_mfma_f32_16x16x32_bf16(a, uf[ks], xa, 0, 0, 0);
            }
            u32x2 o; o[0] = pk2(xa[0], xa[1]); o[1] = pk2(xa[2], xa[3]);
            *(LAS u32x2*)(sc + fr * S5_TROW + (mt * 16 + 4 * fq) * 2) = o;
        }
        asm volatile("s_waitcnt lgkmcnt(0)" ::: "memory");
        const int nj = (nsub - nt * 16) < 16 ? (nsub - nt * 16) : 16;
        for (int j = 0; j < nj; ++j) {
            LAS bf16_t* rowp = (LAS bf16_t*)(sc + j * S5_TROW);
            const float xr = bf2f(rowp[lane]), xi = bf2f(rowp[64 + lane]);
            if (D0) { rowp[lane] = f2bf(sr); rowp[64 + lane] = f2bf(si); }
            const float nr = w8[0] * sr - w8[1] * si + xr;
            const float ni = w8[0] * si + w8[1] * sr + xi;
            sr = nr; si = ni;
        }
        asm volatile("s_waitcnt lgkmcnt(0)" ::: "memory");
        if (D0) {
            bf16x8 sf[4];
#pragma unroll
            for (int ks = 0; ks < 4; ++ks) sf[ks] = *(const LAS bf16x8*)(sc + fr * S5_TROW + (ks * 32 + fq * 8) * 2);
            bf16_t* ys5 = WSP(bf16_t, T_YS5);
            u32x2 uraw[8];
#pragma unroll
            for (int mt = 0; mt < 8; ++mt) uraw[mt] = valid ? *(const u32x2*)(us5 + (size_t)(row0 + sub * 8 + mt) * 512 + g * 16 + 4 * fq) : (u32x2){0u, 0u};
#pragma unroll
            for (int mt = 0; mt < 8; ++mt) {
                f32x4 ya = zero4();
#pragma unroll
                for (int ks = 0; ks < 4; ++ks) {
                    const bf16x8 a = *(const LAS bf16x8*)(tb + S5_TBYTES + (mt * 16 + fr) * S5_TROW + (ks * 32 + fq * 8) * 2);
                    ya = __builtin_amdgcn_mfma_f32_16x16x32_bf16(a, uf[ks], ya, 0, 0, 0);
                }
#pragma unroll
                for (int ks = 0; ks < 4; ++ks) {
                    const bf16x8 a = *(const LAS bf16x8*)(tb + 2 * S5_TBYTES + (mt * 16 + fr) * S5_TROW + (ks * 32 + fq * 8) * 2);
                    ya = __builtin_amdgcn_mfma_f32_16x16x32_bf16(a, sf[ks], ya, 0, 0, 0);
                }
                if (valid) {
                    const int tok = row0 + sub * 8 + mt, ch = g * 16 + 4 * fq;
                    const f32x4 u = unpk4(__uint_as_float(uraw[mt][0]), __uint_as_float(uraw[mt][1]));
                    f32x4 o; o[0] = gelu_tanh(ya[0] + dv[0] * u[0]); o[1] = gelu_tanh(ya[1] + dv[1] * u[1]); o[2] = gelu_tanh(ya[2] + dv[2] * u[2]); o[3] = gelu_tanh(ya[3] + dv[3] * u[3]);
                    st4bf(ys5 + (size_t)tok * 512 + ch, o);
                }
            }
            asm volatile("s_waitcnt lgkmcnt(0)" ::: "memory");
        }
    }
    if (!D0) { f32x2 o; o[0] = sr; o[1] = si; span[((size_t)panel * NG + g) * 64 + lane] = o; }
}
template <bool D0>
__device__ __forceinline__ void s5_phase(const Frame& G, int layer) {
    const Frame F = local_frame(G);
    for (int wu = F.blk; wu < NG * 9; wu += F.nblk) {
        const int g = wu % NG, oct = wu / NG;
        __syncthreads();
        const bf16_t* T = WSP(bf16_t, WS_S5T) + ((size_t)layer * NG + g) * 3 * 16384;
        for (int i = F.tid; i < 3 * 128 * 16; i += NTHREADS) {
            const int tbl = i >> 11, r = (i >> 4) & 127, c = i & 15;
            if (D0 || tbl == 0) *(LAS u32x4*)(F.lds + tbl * S5_TBYTES + r * S5_TROW + c * 16) = *(const u32x4*)(T + (size_t)tbl * 16384 + r * 128 + c * 8);
        }
        __syncthreads();
        const int panel = oct < 8 ? oct * 8 + F.wave : (F.wave == 0 ? 64 : -1);
        if (panel >= 0) s5_wave<D0>(F, layer, g, panel);
    }
}

constexpr int LRU_XROW = 144;
constexpr int LRU_VROW = 68;
constexpr int LRU_OFF_AV = 128 * LRU_XROW;
constexpr int LRU_OFF_BV = LRU_OFF_AV + 128 * LRU_VROW * 4;
constexpr int LRU_OFF_AGG = LRU_OFF_BV + 128 * LRU_VROW * 4;
constexpr int LRU_OFF_CST = LRU_OFF_AGG + 8 * 64 * 8;
constexpr int LRU_OFF_CAR = LRU_OFF_CST + 64 * 16;
template <bool D0>
__device__ __forceinline__ void lru_unit(const Frame& G, int layer, int panel, int head) {
    const Frame F = local_frame(G);
    const int tid = F.tid, lane = F.lane, fr = lane & 15, fq = lane >> 4;
    LAS unsigned char* xcb = F.lds;
    LAS float* av = (LAS float*)(F.lds + LRU_OFF_AV);
    LAS float* bv = (LAS float*)(F.lds + LRU_OFF_BV);
    LAS f32x2* agg = (LAS f32x2*)(F.lds + LRU_OFF_AGG);
    LAS f32x4* cst = (LAS f32x4*)(F.lds + LRU_OFF_CST);
    LAS f32x2* car = (LAS f32x2*)(F.lds + LRU_OFF_CAR);
    const int row0 = panel < 64 ? panel * 256 : NTOK, ntok = panel < 64 ? 256 : 16;
    const bf16_t* xl = WSP(bf16_t, T_XLRU);
    const float* apan = WSP(float, WS_APAN); const float* hpan = WSP(float, WS_HPAN);
    __syncthreads();
    if (tid < 64) {
        const int ch = head * 64 + tid;
        const float lam = F.in[22][(size_t)layer * 512 + ch];
        f32x4 c; c[0] = F.in[19][(size_t)layer * 512 + ch]; c[1] = F.in[21][(size_t)layer * 512 + ch]; { const float x = __expf(-lam); c[2] = (x < 0.05f) ? x * (1.0f - x * (0.5f - x * (0.33333334f - 0.25f * x))) : ((-lam > 20.f) ? -lam : __logf(1.0f + x)); } c[3] = 0.f;
        cst[tid] = c;
    }
    if (D0 && panel < 64) {
        const int c = tid & 63, jg = tid >> 6, ch = head * 64 + c, b0 = (panel >> 5) << 5;
        float A = 1.f, H = 0.f;
#pragma unroll
        for (int q4 = 0; q4 < 4; ++q4) {
            const int q = b0 + jg * 4 + q4;
            if (q < panel) { const float a = apan[q * 512 + ch], h = hpan[q * 512 + ch]; H = a * H + h; A *= a; }
        }
        f32x2 o; o[0] = A; o[1] = H; agg[jg * 64 + c] = o;
        __syncthreads();
        if (tid < 64) {
            float h = hpan[64 * 512 + ch];
#pragma unroll
            for (int j = 0; j < 8; ++j) { const f32x2 g = agg[j * 64 + c]; h = g[0] * h + g[1]; }
            { float one = 1.f; OPAQUE(one); f32x2 o2; o2[0] = h; o2[1] = one; car[c] = o2; }
        }
    } else if (tid < 64) { float z = 0.f; OPAQUE(z); f32x2 o2; o2[0] = z; o2[1] = z + 1.f; car[tid] = o2; }
    bf16x8 wf[2][4][2];
    {
        const bf16_t* lw = WSP(bf16_t, WS_LRUW) + ((size_t)(layer * 8 + head) * 2) * 4096;
#pragma unroll
        for (int g = 0; g < 2; ++g)
#pragma unroll
            for (int nb = 0; nb < 4; ++nb)
#pragma unroll
                for (int ks = 0; ks < 2; ++ks) wf[g][nb][ks] = *(const bf16x8*)(lw + (size_t)g * 4096 + (nb * 16 + fr) * 64 + ks * 32 + fq * 8);
    }
    const int c8 = (tid & 7) * 8;
    float cw[4][8], cbv[8];
#pragma unroll
    for (int w = 0; w < 4; ++w) {
        const f32x4 u0 = *(const f32x4*)(F.in[16] + ((size_t)layer * 4 + w) * 512 + head * 64 + c8), u1 = *(const f32x4*)(F.in[16] + ((size_t)layer * 4 + w) * 512 + head * 64 + c8 + 4);
        cw[w][0] = u0[0]; cw[w][1] = u0[1]; cw[w][2] = u0[2]; cw[w][3] = u0[3]; cw[w][4] = u1[0]; cw[w][5] = u1[1]; cw[w][6] = u1[2]; cw[w][7] = u1[3];
    }
    {
        const f32x4 u0 = *(const f32x4*)(F.in[17] + (size_t)layer * 512 + head * 64 + c8), u1 = *(const f32x4*)(F.in[17] + (size_t)layer * 512 + head * 64 + c8 + 4);
        cbv[0] = u0[0]; cbv[1] = u0[1]; cbv[2] = u0[2]; cbv[3] = u0[3]; cbv[4] = u1[0]; cbv[5] = u1[1]; cbv[6] = u1[2]; cbv[7] = u1[3];
    }
    u32x4 xr[2][4];
#define LRU_LOADX(T0, NREM) do { _Pragma("unroll") for (int _ps = 0; _ps < 2; ++_ps) _Pragma("unroll") for (int _w = 0; _w < 4; ++_w) { \
        const int _t = _ps * 64 + (tid >> 3), _tok = (T0) + _t - 3 + _w; bool _have = _t < (NREM); size_t _row; \
        if (_tok >= 0) _row = (size_t)(row0 + _tok); else if (panel >= 64) { _have = false; _row = 0; } else if ((panel & 31) == 0) _row = (size_t)(NTOK + NMETA + _tok); else _row = (size_t)(row0 + _tok); \
        xr[_ps][_w] = _have ? *(const u32x4*)(xl + _row * 512 + head * 64 + c8) : (u32x4){0u, 0u, 0u, 0u}; } } while (0)
    LRU_LOADX(0, ntok);
    int half = 0;
    for (int t0 = 0; t0 < ntok; t0 += 128, ++half) {
        const int nth = (ntok - t0) < 128 ? (ntok - t0) : 128;
        u32x4 gvv[2];
        if (D0) {
            const int t4 = tid >> 2;
            const bf16_t* gg = WSP(bf16_t, T_GG) + (size_t)(row0 + t0 + (t4 < nth ? t4 : 0)) * 512 + head * 64 + (tid & 3) * 16;
#pragma unroll
            for (int q = 0; q < 2; ++q) gvv[q] = *(const u32x4*)(gg + q * 8);
        }
#pragma unroll
        for (int ps = 0; ps < 2; ++ps) {
            const int t = ps * 64 + (tid >> 3);
            float xc[8];
#pragma unroll
            for (int i = 0; i < 8; ++i) xc[i] = cbv[i];
#pragma unroll
            for (int w = 0; w < 4; ++w) {
                const u32x4 v = xr[ps][w];
#pragma unroll
                for (int i = 0; i < 4; ++i) { xc[2 * i] += cw[w][2 * i] * __uint_as_float(v[i] << 16); xc[2 * i + 1] += cw[w][2 * i + 1] * __uint_as_float(v[i] & 0xffff0000u); }
            }
            if (t >= nth) {
#pragma unroll
                for (int i = 0; i < 8; ++i) xc[i] = 0.f;
            }
            u32x4 o; o[0] = pk2(xc[0], xc[1]); o[1] = pk2(xc[2], xc[3]); o[2] = pk2(xc[4], xc[5]); o[3] = pk2(xc[6], xc[7]);
            *(LAS u32x4*)(xcb + t * LRU_XROW + c8 * 2) = o;
        }
        if (t0 + 128 < ntok) { LRU_LOADX(t0 + 128, ntok - t0 - 128); }
        __syncthreads();
        {
            const int tk = F.wave * 16 + fr;
            bf16x8 xf[2];
#pragma unroll
            for (int ks = 0; ks < 2; ++ks) xf[ks] = *(const LAS bf16x8*)(xcb + tk * LRU_XROW + (ks * 32 + fq * 8) * 2);
#pragma unroll
            for (int nb = 0; nb < 4; ++nb) {
                f32x4 ar = zero4(), ai = zero4();
#pragma unroll
                for (int ks = 0; ks < 2; ++ks) { ar = __builtin_amdgcn_mfma_f32_16x16x32_bf16(wf[0][nb][ks], xf[ks], ar, 0, 0, 0); ai = __builtin_amdgcn_mfma_f32_16x16x32_bf16(wf[1][nb][ks], xf[ks], ai, 0, 0, 0); }
                const int ch = nb * 16 + 4 * fq;
                const u32x2 xv = *(const LAS u32x2*)(xcb + tk * LRU_XROW + ch * 2);
                float xcv[4]; xcv[0] = __uint_as_float(xv[0] << 16); xcv[1] = __uint_as_float(xv[0] & 0xffff0000u); xcv[2] = __uint_as_float(xv[1] << 16); xcv[3] = __uint_as_float(xv[1] & 0xffff0000u);
                f32x4 ao, bo;
#pragma unroll
                for (int r = 0; r < 4; ++r) {
                    const f32x4 c = cst[ch + r];
                    const float rg = sigmoidf_(ar[r] + c[0]), ig = sigmoidf_(ai[r] + c[1]);
                    const float la = -8.0f * rg * c[2];
                    ao[r] = (tk < nth) ? __expf(la) : 1.0f;
                    bo[r] = (tk < nth) ? __builtin_amdgcn_sqrtf(one_minus_exp(2.0f * la)) * (ig * xcv[r]) : 0.0f;
                }
                *(LAS f32x4*)(av + tk * LRU_VROW + ch) = ao;
                *(LAS f32x4*)(bv + tk * LRU_VROW + ch) = bo;
            }
        }
        __syncthreads();
        {
            const int c = tid & 63, seg = tid >> 6;
            float A = 1.f, H = 0.f;
#pragma unroll
            for (int t = 0; t < 16; ++t) { const float a = av[(seg * 16 + t) * LRU_VROW + c]; H = a * H + bv[(seg * 16 + t) * LRU_VROW + c]; A *= a; }
            f32x2 o; o[0] = A; o[1] = H; agg[seg * 64 + c] = o;
            __syncthreads();
            const f32x2 cin = car[(half & 1) * 64 + c];
            float h = cin[0], P = cin[1];
            if (D0) {
                for (int s = 0; s < seg; ++s) { const f32x2 g = agg[s * 64 + c]; h = g[0] * h + g[1]; }
#pragma unroll
                for (int t = 0; t < 16; ++t) { h = av[(seg * 16 + t) * LRU_VROW + c] * h + bv[(seg * 16 + t) * LRU_VROW + c]; bv[(seg * 16 + t) * LRU_VROW + c] = h; }
                if (seg == 7) { float one = 1.f; OPAQUE(one); f32x2 o2; o2[0] = h; o2[1] = one; car[((half + 1) & 1) * 64 + c] = o2; }
            } else if (seg == 7) {
#pragma unroll
                for (int s = 0; s < 8; ++s) { const f32x2 g = agg[s * 64 + c]; h = g[0] * h + g[1]; P *= g[0]; }
                f32x2 o2; o2[0] = h; o2[1] = P; car[((half + 1) & 1) * 64 + c] = o2;
            }
        }
        __syncthreads();
        if (D0) {
            const int t = tid >> 2, c16 = (tid & 3) * 16;
            if (t < nth) {
                const size_t row = (size_t)(row0 + t0 + t);
                bf16_t* so = WSP(bf16_t, T_SOLO) + row * D + 512 + head * 64 + c16;
#pragma unroll
                for (int q = 0; q < 2; ++q) {
                    const u32x4 gv = gvv[q];
                    const f32x4 h0 = *(const LAS f32x4*)(bv + t * LRU_VROW + c16 + q * 8), h1 = *(const LAS f32x4*)(bv + t * LRU_VROW + c16 + q * 8 + 4);
                    u32x4 o;
                    o[0] = pk2(h0[0] * __uint_as_float(gv[0] << 16), h0[1] * __uint_as_float(gv[0] & 0xffff0000u));
                    o[1] = pk2(h0[2] * __uint_as_float(gv[1] << 16), h0[3] * __uint_as_float(gv[1] & 0xffff0000u));
                    o[2] = pk2(h1[0] * __uint_as_float(gv[2] << 16), h1[1] * __uint_as_float(gv[2] & 0xffff0000u));
                    o[3] = pk2(h1[2] * __uint_as_float(gv[3] << 16), h1[3] * __uint_as_float(gv[3] & 0xffff0000u));
                    *(u32x4*)(so + q * 8) = o;
                }
            }
        }
    }
    if (!D0) {
        __syncthreads();
        if (tid < 64) { const f32x2 o = car[(half & 1) * 64 + tid]; WSP(float, WS_APAN)[panel * 512 + head * 64 + tid] = o[1]; WSP(float, WS_HPAN)[panel * 512 + head * 64 + tid] = o[0]; }
    }
}


#define RLX_AGENT __ATOMIC_RELAXED, __HIP_MEMORY_SCOPE_AGENT
constexpr unsigned LB_SPIN_CAP = 1u << 22;
__device__ __forceinline__ void lb_publish64(unsigned long long* pay, unsigned long long v, unsigned* flag, unsigned epoch, int lane) {
    __hip_atomic_store(pay + lane, v, RLX_AGENT);
    asm volatile("s_waitcnt vmcnt(0)" ::: "memory");
    if (lane == 0) __hip_atomic_store(flag, epoch, RLX_AGENT);
}
__device__ __forceinline__ void lb_wait(const unsigned* myflag, bool need, unsigned epoch) {
    unsigned sp = 0;
    for (;;) {
        const bool ok = !need || __hip_atomic_load(myflag, RLX_AGENT) >= epoch;
        if (__all(ok)) break;
        __builtin_amdgcn_s_sleep(2);
        if (++sp > LB_SPIN_CAP) break;
    }
}
__device__ __forceinline__ f32x2 lb_load2(const f32x2* p) { const unsigned long long b = __hip_atomic_load((const unsigned long long*)p, RLX_AGENT); f32x2 r; r[0] = __uint_as_float((unsigned)b); r[1] = __uint_as_float((unsigned)(b >> 32)); return r; }
__device__ __forceinline__ unsigned long long pack2(float a, float b) { return (unsigned long long)__float_as_uint(a) | ((unsigned long long)__float_as_uint(b) << 32); }
__device__ __forceinline__ unsigned short f2h(float x) { return __builtin_bit_cast(unsigned short, (_Float16)x); }
__device__ __forceinline__ float h2f(unsigned short h) { return (float)__builtin_bit_cast(_Float16, h); }

constexpr int LSP_OFF_AV = 128 * LRU_XROW;
constexpr int LSP_OFF_BV = LSP_OFF_AV + 2 * 128 * LRU_VROW * 4;
constexpr int LSP_BROW = 144;
constexpr int LSP_OFF_AGG = LSP_OFF_BV + 2 * 128 * LSP_BROW;
constexpr int LSP_OFF_CST = LSP_OFF_AGG + 16 * 64 * 8;
constexpr int LSP_OFF_CAR = LSP_OFF_CST + 64 * 16;
constexpr int LSP_OFF_GRP = LSP_OFF_CAR + 64 * 8;
static_assert(LSP_OFF_GRP + 8 * 64 * 8 <= 147392 - 64, "lru lds");
__device__ __forceinline__ void lru_unit_sp(const Frame& G, int layer, int panel, int head) {
    const Frame F = local_frame(G);
    const int tid = F.tid, lane = F.lane, fr = lane & 15, fq = lane >> 4;
    LAS unsigned char* xcb = F.lds;
    LAS float* avb = (LAS float*)(F.lds + LSP_OFF_AV);
    LAS unsigned char* bvb = F.lds + LSP_OFF_BV;
    LAS f32x2* agg = (LAS f32x2*)(F.lds + LSP_OFF_AGG);
    LAS f32x4* cst = (LAS f32x4*)(F.lds + LSP_OFF_CST);
    LAS float* car = (LAS float*)(F.lds + LSP_OFF_CAR);
    LAS f32x2* grp = (LAS f32x2*)(F.lds + LSP_OFF_GRP);
    const int row0 = panel < 64 ? panel * 256 : NTOK, ntok = panel < 64 ? 256 : 16, nh = panel < 64 ? 2 : 1;
    const bf16_t* xl = WSP(bf16_t, T_XLRU);
    f32x2* lpay = WSP(f32x2, WS_APAN);
    unsigned* lflag = (unsigned*)(F.ws + WS_LFLAG);
    const unsigned epoch = (unsigned)layer + 1u;
    __syncthreads();
    if (tid < 64) {
        const int ch = head * 64 + tid;
        const float lam = F.in[22][(size_t)layer * 512 + ch];
        f32x4 c; c[0] = F.in[19][(size_t)layer * 512 + ch]; c[1] = F.in[21][(size_t)layer * 512 + ch];
        { const float x = __expf(-lam); c[2] = (x < 0.05f) ? x * (1.0f - x * (0.5f - x * (0.33333334f - 0.25f * x))) : ((-lam > 20.f) ? -lam : __logf(1.0f + x)); } c[3] = 0.f;
        cst[tid] = c;
    }
    bf16x8 wf[2][4][2];
    {
        const bf16_t* lw = WSP(bf16_t, WS_LRUW) + ((size_t)(layer * 8 + head) * 2) * 4096;
#pragma unroll
        for (int g = 0; g < 2; ++g)
#pragma unroll
            for (int nb = 0; nb < 4; ++nb)
#pragma unroll
                for (int ks = 0; ks < 2; ++ks) wf[g][nb][ks] = *(const bf16x8*)(lw + (size_t)g * 4096 + (nb * 16 + fr) * 64 + ks * 32 + fq * 8);
    }
    const int c8 = (tid & 7) * 8;
    float cw[4][8], cbv[8];
#pragma unroll
    for (int w = 0; w < 4; ++w) {
        const f32x4 u0 = *(const f32x4*)(F.in[16] + ((size_t)layer * 4 + w) * 512 + head * 64 + c8), u1 = *(const f32x4*)(F.in[16] + ((size_t)layer * 4 + w) * 512 + head * 64 + c8 + 4);
        cw[w][0] = u0[0]; cw[w][1] = u0[1]; cw[w][2] = u0[2]; cw[w][3] = u0[3]; cw[w][4] = u1[0]; cw[w][5] = u1[1]; cw[w][6] = u1[2]; cw[w][7] = u1[3];
    }
    {
        const f32x4 u0 = *(const f32x4*)(F.in[17] + (size_t)layer * 512 + head * 64 + c8), u1 = *(const f32x4*)(F.in[17] + (size_t)layer * 512 + head * 64 + c8 + 4);
        cbv[0] = u0[0]; cbv[1] = u0[1]; cbv[2] = u0[2]; cbv[3] = u0[3]; cbv[4] = u1[0]; cbv[5] = u1[1]; cbv[6] = u1[2]; cbv[7] = u1[3];
    }
    u32x4 xr[2][4];
    LRU_LOADX(0, ntok);
    for (int half = 0; half < nh; ++half) {
        const int t0 = half * 128, nth = (ntok - t0) < 128 ? (ntok - t0) : 128;
        LAS float* av = avb + half * 128 * LRU_VROW;
        LAS unsigned char* bv = bvb + half * 128 * LSP_BROW;
#pragma unroll
        for (int ps = 0; ps < 2; ++ps) {
            const int t = ps * 64 + (tid >> 3);
            float xc[8];
#pragma unroll
            for (int i = 0; i < 8; ++i) xc[i] = cbv[i];
#pragma unroll
            for (int w = 0; w < 4; ++w) {
                const u32x4 v = xr[ps][w];
#pragma unroll
                for (int i = 0; i < 4; ++i) { xc[2 * i] += cw[w][2 * i] * __uint_as_float(v[i] << 16); xc[2 * i + 1] += cw[w][2 * i + 1] * __uint_as_float(v[i] & 0xffff0000u); }
            }
            if (t >= nth) {
#pragma unroll
                for (int i = 0; i < 8; ++i) xc[i] = 0.f;
            }
            u32x4 o; o[0] = pk2(xc[0], xc[1]); o[1] = pk2(xc[2], xc[3]); o[2] = pk2(xc[4], xc[5]); o[3] = pk2(xc[6], xc[7]);
            *(LAS u32x4*)(xcb + t * LRU_XROW + c8 * 2) = o;
        }
        if (half + 1 < nh) { LRU_LOADX(t0 + 128, ntok - t0 - 128); }
        __syncthreads();
        {
            const int tk = F.wave * 16 + fr;
            bf16x8 xf[2];
#pragma unroll
            for (int ks = 0; ks < 2; ++ks) xf[ks] = *(const LAS bf16x8*)(xcb + tk * LRU_XROW + (ks * 32 + fq * 8) * 2);
#pragma unroll
            for (int nb = 0; nb < 4; ++nb) {
                f32x4 ar = zero4(), ai = zero4();
#pragma unroll
                for (int ks = 0; ks < 2; ++ks) { ar = __builtin_amdgcn_mfma_f32_16x16x32_bf16(wf[0][nb][ks], xf[ks], ar, 0, 0, 0); ai = __builtin_amdgcn_mfma_f32_16x16x32_bf16(wf[1][nb][ks], xf[ks], ai, 0, 0, 0); }
                const int ch = nb * 16 + 4 * fq;
                const u32x2 xv = *(const LAS u32x2*)(xcb + tk * LRU_XROW + ch * 2);
                float xcv[4]; xcv[0] = __uint_as_float(xv[0] << 16); xcv[1] = __uint_as_float(xv[0] & 0xffff0000u); xcv[2] = __uint_as_float(xv[1] << 16); xcv[3] = __uint_as_float(xv[1] & 0xffff0000u);
                f32x4 ao; float bo[4];
#pragma unroll
                for (int r = 0; r < 4; ++r) {
                    const f32x4 c = cst[ch + r];
                    const float rg = sigmoidf_(ar[r] + c[0]), ig = sigmoidf_(ai[r] + c[1]);
                    const float la = -8.0f * rg * c[2];
                    ao[r] = (tk < nth) ? __expf(la) : 1.0f;
                    bo[r] = (tk < nth) ? __builtin_amdgcn_sqrtf(one_minus_exp(2.0f * la)) * (ig * xcv[r]) : 0.0f;
                }
                *(LAS f32x4*)(av + tk * LRU_VROW + ch) = ao;
                u32x2 bh; bh[0] = (unsigned)f2h(bo[0]) | ((unsigned)f2h(bo[1]) << 16); bh[1] = (unsigned)f2h(bo[2]) | ((unsigned)f2h(bo[3]) << 16);
                *(LAS u32x2*)(bv + tk * LSP_BROW + ch * 2) = bh;
            }
        }
        __syncthreads();
        {
            const int c = tid & 63, seg = tid >> 6;
            float A = 1.f, H = 0.f;
#pragma unroll
            for (int t = 0; t < 16; ++t) { const float a = av[(seg * 16 + t) * LRU_VROW + c]; H = a * H + h2f(*(const LAS unsigned short*)(bv + (seg * 16 + t) * LSP_BROW + c * 2)); A *= a; }
            f32x2 o; o[0] = A; o[1] = H; agg[(half * 8 + seg) * 64 + c] = o;
        }
    }
    __syncthreads();
    if (F.wave == 0) {
        float A = 1.f, H = 0.f;
        for (int s = 0; s < nh * 8; ++s) { const f32x2 g = agg[s * 64 + lane]; H = g[0] * H + g[1]; A *= g[0]; }
        lb_publish64((unsigned long long*)(lpay + (size_t)panel * 512 + head * 64), pack2(A, H), lflag + (size_t)(panel * 8 + head) * 16, epoch, lane);
        if (panel < 64) {
            const int b0 = (panel >> 5) << 5, q = (lane < 32) ? b0 + lane : 64;
            const bool need = (lane < 32) ? (q < panel) : (lane == 32);
            lb_wait(lflag + (size_t)(q * 8 + head) * 16, need, epoch);
        }
    }
    __syncthreads();
    if (panel < 64) {
        const int c = tid & 63, jg = tid >> 6, b0 = (panel >> 5) << 5;
        float A = 1.f, H = 0.f;
#pragma unroll
        for (int q4 = 0; q4 < 4; ++q4) {
            const int q = b0 + jg * 4 + q4;
            if (q < panel) { const f32x2 g = lb_load2(lpay + (size_t)q * 512 + head * 64 + c); H = g[0] * H + g[1]; A *= g[0]; }
        }
        f32x2 o; o[0] = A; o[1] = H; grp[jg * 64 + c] = o;
        __syncthreads();
        if (tid < 64) {
            float h = lb_load2(lpay + (size_t)64 * 512 + head * 64 + c)[1];
#pragma unroll
            for (int j = 0; j < 8; ++j) { const f32x2 g = grp[j * 64 + c]; h = g[0] * h + g[1]; }
            car[c] = h;
        }
    } else if (tid < 64) { float z = 0.f; OPAQUE(z); car[tid] = z; }
    __syncthreads();
    for (int half = 0; half < nh; ++half) {
        const int t0 = half * 128, nth = (ntok - t0) < 128 ? (ntok - t0) : 128;
        LAS float* av = avb + half * 128 * LRU_VROW;
        LAS unsigned char* bv = bvb + half * 128 * LSP_BROW;
        u32x4 gvv[2];
        {
            const int t4 = tid >> 2;
            const bf16_t* gg = WSP(bf16_t, T_GG) + (size_t)(row0 + t0 + (t4 < nth ? t4 : 0)) * 512 + head * 64 + (tid & 3) * 16;
#pragma unroll
            for (int q = 0; q < 2; ++q) gvv[q] = *(const u32x4*)(gg + q * 8);
        }
        {
            const int c = tid & 63, seg = tid >> 6;
            float h = car[c];
            for (int s = 0; s < half * 8 + seg; ++s) { const f32x2 g = agg[s * 64 + c]; h = g[0] * h + g[1]; }
#pragma unroll
            for (int t = 0; t < 16; ++t) {
                LAS unsigned short* bp = (LAS unsigned short*)(bv + (seg * 16 + t) * LSP_BROW + c * 2);
                h = av[(seg * 16 + t) * LRU_VROW + c] * h + h2f(*bp); *bp = f2h(h);
            }
        }
        __syncthreads();
        {
            const int t = tid >> 2, c16 = (tid & 3) * 16;
            if (t < nth) {
                const size_t row = (size_t)(row0 + t0 + t);
                bf16_t* so = WSP(bf16_t, T_SOLO) + row * D + 512 + head * 64 + c16;
#pragma unroll
                for (int q = 0; q < 2; ++q) {
                    const u32x4 gv = gvv[q];
                    const u32x4 hv = *(const LAS u32x4*)(bv + t * LSP_BROW + (c16 + q * 8) * 2);
                    u32x4 o;
#pragma unroll
                    for (int i = 0; i < 4; ++i) o[i] = pk2(h2f((unsigned short)(hv[i] & 0xffffu)) * __uint_as_float(gv[i] << 16), h2f((unsigned short)(hv[i] >> 16)) * __uint_as_float(gv[i] & 0xffff0000u));
                    *(u32x4*)(so + q * 8) = o;
                }
            }
        }
    }
}

__device__ __forceinline__ void s5_load_u(const Frame& F, int g, int panel, bf16x8 (&ufa)[2][4]) {
    const int lane = F.lane, fr = lane & 15, fq = lane >> 4;
    const int row0 = panel < 64 ? panel * 256 : NTOK, nsub = panel < 64 ? 32 : 2;
    const bf16_t* us5 = WSP(bf16_t, T_US5);
#pragma unroll
    for (int nt = 0; nt < 2; ++nt)
#pragma unroll
        for (int ks = 0; ks < 4; ++ks) {
            const int sub = nt * 16 + fr;
            const int tok = row0 + sub * 8 + 2 * ks + (fq >> 1);
            ufa[nt][ks] = (panel >= 0 && sub < nsub) ? *(const bf16x8*)(us5 + (size_t)tok * 512 + g * 16 + (fq & 1) * 8) : (bf16x8){0, 0, 0, 0, 0, 0, 0, 0};
        }
}
__device__ __forceinline__ void s5_wave_sp(const Frame& F, int layer, int g, int panel, const bf16x8 (&ufa)[2][4]) {
    const int lane = F.lane, fr = lane & 15, fq = lane >> 4;
    const int row0 = panel < 64 ? panel * 256 : NTOK, nsub = panel < 64 ? 32 : 2;
    LAS unsigned char* tb = F.lds;
    LAS unsigned char* sc = F.lds + S5_SC_OFF + F.wave * S5_SC_BYTES;
    const bf16_t* us5 = WSP(bf16_t, T_US5);
    f32x2* span = WSP(f32x2, WS_SPAN);
    unsigned* sflag = (unsigned*)(F.ws + WS_SFLAG);
    const unsigned epoch = (unsigned)layer + 1u;
    const f32x2 w8 = WSP(f32x2, WS_W8)[((size_t)layer * NG + g) * 64 + lane];
    float slr[32], sli[32];
    float sr = 0.f, si = 0.f;
#pragma unroll
    for (int nt = 0; nt < 2; ++nt) {
        if (nt * 16 < nsub) {
#pragma unroll
            for (int mt = 0; mt < 8; ++mt) {
                f32x4 xa = zero4();
#pragma unroll
                for (int ks = 0; ks < 4; ++ks) {
                    const bf16x8 a = *(const LAS bf16x8*)(tb + (mt * 16 + fr) * S5_TROW + (ks * 32 + fq * 8) * 2);
                    xa = __builtin_amdgcn_mfma_f32_16x16x32_bf16(a, ufa[nt][ks], xa, 0, 0, 0);
                }
                u32x2 o; o[0] = pk2(xa[0], xa[1]); o[1] = pk2(xa[2], xa[3]);
                *(LAS u32x2*)(sc + fr * S5_TROW + (mt * 16 + 4 * fq) * 2) = o;
            }
            asm volatile("s_waitcnt lgkmcnt(0)" ::: "memory");
#pragma unroll
            for (int j = 0; j < 16; ++j) {
                const LAS bf16_t* rowp = (const LAS bf16_t*)(sc + j * S5_TROW);
                const float xr = bf2f(rowp[lane]), xi = bf2f(rowp[64 + lane]);
                slr[nt * 16 + j] = sr; sli[nt * 16 + j] = si;
                if (nt * 16 + j < nsub) {
                    const float nr = w8[0] * sr - w8[1] * si + xr;
                    const float ni = w8[0] * si + w8[1] * sr + xi;
                    sr = nr; si = ni;
                }
            }
            asm volatile("s_waitcnt lgkmcnt(0)" ::: "memory");
        } else {
#pragma unroll
            for (int j = 0; j < 16; ++j) { slr[nt * 16 + j] = 0.f; sli[nt * 16 + j] = 0.f; }
        }
    }
    lb_publish64((unsigned long long*)(span + ((size_t)panel * NG + g) * 64), pack2(sr, si), sflag + (size_t)(panel * NG + g) * 16, epoch, lane);
    const float* dsk = F.in[12] + (size_t)layer * S5W + g * 16 + 4 * fq;
    const f32x4 dv = *(const f32x4*)dsk;
    u32x2 uraw0[8];
#pragma unroll
    for (int mt = 0; mt < 8; ++mt) uraw0[mt] = (fr < nsub) ? *(const u32x2*)(us5 + (size_t)(row0 + fr * 8 + mt) * 512 + g * 16 + 4 * fq) : (u32x2){0u, 0u};
    u32x2 uraw1[8];
#pragma unroll
    for (int mt = 0; mt < 8; ++mt) uraw1[mt] = (16 + fr < nsub) ? *(const u32x2*)(us5 + (size_t)(row0 + (16 + fr) * 8 + mt) * 512 + g * 16 + 4 * fq) : (u32x2){0u, 0u};
    float cr = 0.f, ci = 0.f;
    if (panel < 64) {
        const int b0 = (panel >> 5) << 5, q = (lane < 32) ? b0 + lane : 64;
        const bool need = (lane < 32) ? (q < panel) : (lane == 32);
        lb_wait(sflag + (size_t)(q * NG + g) * 16, need, epoch);
        const f32x2 w256 = WSP(f32x2, WS_W256)[((size_t)layer * NG + g) * 64 + lane];
        const f32x2 sm = lb_load2(span + ((size_t)64 * NG + g) * 64 + lane);
        cr = sm[0]; ci = sm[1];
        for (int qb = b0; qb < panel; qb += 8) {
            f32x2 x[8];
#pragma unroll
            for (int i = 0; i < 8; ++i) { const int q2 = (qb + i < panel) ? qb + i : panel - 1; x[i] = lb_load2(span + ((size_t)q2 * NG + g) * 64 + lane); }
#pragma unroll
            for (int i = 0; i < 8; ++i) {
                if (qb + i < panel) {
                    const float nr = w256[0] * cr - w256[1] * ci + x[i][0];
                    const float ni = w256[0] * ci + w256[1] * cr + x[i][1];
                    cr = nr; ci = ni;
                }
            }
        }
    }
    bf16_t* ys5 = WSP(bf16_t, T_YS5);
    float pr = 1.f, pi = 0.f;
#pragma unroll
    for (int nt = 0; nt < 2; ++nt) {
        if (nt * 16 < nsub) {
            const int sub = nt * 16 + fr; const bool valid = sub < nsub;
#pragma unroll
            for (int j = 0; j < 16; ++j) {
                LAS bf16_t* rowp = (LAS bf16_t*)(sc + j * S5_TROW);
                rowp[lane] = f2bf(slr[nt * 16 + j] + pr * cr - pi * ci);
                rowp[64 + lane] = f2bf(sli[nt * 16 + j] + pr * ci + pi * cr);
                const float nr = pr * w8[0] - pi * w8[1], ni = pr * w8[1] + pi * w8[0];
                pr = nr; pi = ni;
            }
            asm volatile("s_waitcnt lgkmcnt(0)" ::: "memory");
            bf16x8 sf[4];
#pragma unroll
            for (int ks = 0; ks < 4; ++ks) sf[ks] = *(const LAS bf16x8*)(sc + fr * S5_TROW + (ks * 32 + fq * 8) * 2);
            u32x2 uraw[8];
#pragma unroll
            for (int mt = 0; mt < 8; ++mt) uraw[mt] = (nt == 0) ? uraw0[mt] : uraw1[mt];
#pragma unroll
            for (int mt = 0; mt < 8; ++mt) {
                f32x4 ya = zero4();
#pragma unroll
                for (int ks = 0; ks < 4; ++ks) {
                    const bf16x8 a = *(const LAS bf16x8*)(tb + S5_TBYTES + (mt * 16 + fr) * S5_TROW + (ks * 32 + fq * 8) * 2);
                    ya = __builtin_amdgcn_mfma_f32_16x16x32_bf16(a, ufa[nt][ks], ya, 0, 0, 0);
                }
#pragma unroll
                for (int ks = 0; ks < 4; ++ks) {
                    const bf16x8 a = *(const LAS bf16x8*)(tb + 2 * S5_TBYTES + (mt * 16 + fr) * S5_TROW + (ks * 32 + fq * 8) * 2);
                    ya = __builtin_amdgcn_mfma_f32_16x16x32_bf16(a, sf[ks], ya, 0, 0, 0);
                }
                if (valid) {
                    const int tok = row0 + sub * 8 + mt, ch = g * 16 + 4 * fq;
                    const f32x4 u = unpk4(__uint_as_float(uraw[mt][0]), __uint_as_float(uraw[mt][1]));
                    f32x4 o; o[0] = gelu_tanh(ya[0] + dv[0] * u[0]); o[1] = gelu_tanh(ya[1] + dv[1] * u[1]); o[2] = gelu_tanh(ya[2] + dv[2] * u[2]); o[3] = gelu_tanh(ya[3] + dv[3] * u[3]);
                    st4bf(ys5 + (size_t)tok * 512 + ch, o);
                }
            }
            asm volatile("s_waitcnt lgkmcnt(0)" ::: "memory");
        }
    }
}
__device__ __forceinline__ void s5_phase_sp(const Frame& G, int layer, int first, int stride) {
    const Frame F = local_frame(G);
    for (int wu = first; wu < NG * 9; wu += stride) {
        const int g = wu % NG, oct = wu / NG - 1;
        const int panel = oct >= 0 ? oct * 8 + F.wave : (F.wave == 0 ? 64 : -1);
        bf16x8 ufa[2][4];
        s5_load_u(F, g, panel, ufa);
        __syncthreads();
        const bf16_t* T = WSP(bf16_t, WS_S5T) + ((size_t)layer * NG + g) * 3 * 16384;
        for (int i = F.tid; i < 3 * 128 * 16; i += NTHREADS) {
            const int tbl = i >> 11, r = (i >> 4) & 127, c = i & 15;
            *(LAS u32x4*)(F.lds + tbl * S5_TBYTES + r * S5_TROW + c * 16) = *(const u32x4*)(T + (size_t)tbl * 16384 + r * 128 + c * 8);
        }
        __syncthreads();
        if (panel >= 0) s5_wave_sp(F, layer, g, panel, ufa);
    }
}

__device__ __forceinline__ void moe_router(const Frame& G, int layer, int c_lo, int c_hi) {
    const Frame F = local_frame(G);
    const int j = layer >> 1;
    LAS float* gw = (LAS float*)F.lds;
    LAS int* esel = (LAS int*)(gw + 8 * 1028);
    const float* fn = F.in[25] + (size_t)layer * D; const float* rw = F.in[29] + (size_t)j * D * 8; const float* rb = F.in[30] + j * 8;
    __syncthreads();
    for (int i = F.tid; i < 8192; i += NTHREADS) gw[(i & 7) * 1028 + (i >> 3)] = fn[i >> 3] * rw[i];
    const float* hs = WSP(float, WS_HS);
    int* tope = WSP(int, WS_TOPE); float* topg = WSP(float, WS_TOPG); float* rinv = WSP(float, WS_RINV); int* cnt = WSP(int, WS_CNT);
    for (int chunk = (c_lo < 0 ? F.blk : c_lo); chunk < c_hi; chunk += (c_lo < 0 ? F.nblk : 1)) {
        __syncthreads();
        for (int ps = 0; ps < 2; ++ps) {
            const int rl = F.wave * 8 + ps * 4 + (F.lane >> 4), row = chunk * 64 + rl, l16 = F.lane & 15;
            const bool rv = row < NV;
            float ss = 0.f, lg[8];
#pragma unroll
            for (int e = 0; e < 8; ++e) lg[e] = 0.f;
            f32x4 hv[16];
#pragma unroll
            for (int i = 0; i < 16; ++i) hv[i] = rv ? *(const f32x4*)(hs + (size_t)row * D + i * 64 + l16 * 4) : zero4();
#pragma unroll
            for (int i = 0; i < 16; ++i) {
                const int k = i * 64 + l16 * 4;
                const f32x4 v = hv[i];
                ss += v[0] * v[0] + v[1] * v[1] + v[2] * v[2] + v[3] * v[3];
#pragma unroll
                for (int e = 0; e < 8; ++e) {
                    const f32x4 w = *(const LAS f32x4*)(gw + e * 1028 + k);
                    lg[e] += v[0] * w[0] + v[1] * w[1] + v[2] * w[2] + v[3] * w[3];
                }
            }
#pragma unroll
            for (int o = 8; o >= 1; o >>= 1) {
                ss += shflx(ss, F.lane, o);
#pragma unroll
                for (int e = 0; e < 8; ++e) lg[e] += shflx(lg[e], F.lane, o);
            }
            if (rv) {
                const float ri = rsqrtf(ss * (1.0f / D) + EPS);
                int e0 = 0; float l0 = -3.0e38f;
#pragma unroll
                for (int e = 0; e < 8; ++e) { lg[e] = lg[e] * ri + rb[e]; if (lg[e] > l0) { l0 = lg[e]; e0 = e; } }
                int e1 = 0; float l1 = -3.0e38f;
#pragma unroll
                for (int e = 0; e < 8; ++e) { if (e != e0 && lg[e] > l1) { l1 = lg[e]; e1 = e; } }
                const float g0 = 1.0f / (1.0f + __expf(l1 - l0)), g1 = 1.0f - g0;
                if (l16 == 0) { tope[row * 2] = e0; tope[row * 2 + 1] = e1; topg[row * 2] = g0; topg[row * 2 + 1] = g1; rinv[row] = ri; esel[rl * 2] = e0; esel[rl * 2 + 1] = e1; }
            } else if (l16 == 0) { int m1 = -1; OPAQUE(m1); esel[rl * 2] = m1; esel[rl * 2 + 1] = m1; }
        }
        __syncthreads();
        if (F.tid < 8) { int n = 0; for (int i = 0; i < 128; ++i) n += (esel[i] == F.tid) ? 1 : 0; cnt[chunk * 8 + F.tid] = n; }
    }
}
__device__ __forceinline__ void moe_dispatch(const Frame& G) {
    const Frame F = local_frame(G);
    LAS int* pre = (LAS int*)F.lds;
    LAS int* tot = pre + NCHUNK * 8;
    const int* cnt = WSP(int, WS_CNT);
    const int* tope = WSP(int, WS_TOPE); const float* topg = WSP(float, WS_TOPG);
    int* stok = WSP(int, WS_STOK); float* sgate = WSP(float, WS_SGATE); int* tslot = WSP(int, WS_TSLOT); int* texp = WSP(int, WS_TEXP);
    __syncthreads();
    {
        const int e = F.wave, l = F.lane;
        const int v0 = cnt[(4 * l + 0) * 8 + e], v1 = cnt[(4 * l + 1) * 8 + e], v2 = cnt[(4 * l + 2) * 8 + e], v3 = cnt[(4 * l + 3) * 8 + e];
        const int v4 = (l == 63) ? cnt[256 * 8 + e] : 0;
        const int local = v0 + v1 + v2 + v3 + v4;
        int inc = local;
#pragma unroll
        for (int o = 1; o < 64; o <<= 1) { const int t = shfl_up_i(inc, l, o); if (l >= o) inc += t; }
        const int exc = inc - local;
        pre[(4 * l + 0) * 8 + e] = exc; pre[(4 * l + 1) * 8 + e] = exc + v0; pre[(4 * l + 2) * 8 + e] = exc + v0 + v1; pre[(4 * l + 3) * 8 + e] = exc + v0 + v1 + v2;
        if (l == 63) { pre[256 * 8 + e] = exc + v0 + v1 + v2 + v3; tot[e] = inc; }
    }
    __syncthreads();
    if (F.tid == 0) { int st = 0; for (int e = 0; e < 8; ++e) { tot[8 + e] = st; st += ((tot[e] + 255) >> 8) << 8; } tot[16] = st >> 8; }
    __syncthreads();
    if (F.blk == 0) {
        const int ntile = tot[16];
        for (int t = F.tid; t < ntile; t += NTHREADS) { int e = 0; for (int x = 1; x < 8; ++x) if (t * 256 >= tot[8 + x]) e = x; texp[t] = e; }
        if (F.tid == 0) texp[200] = ntile;
        for (int e = 0; e < 8; ++e) {
            const int lo = tot[8 + e] + tot[e], hi = tot[8 + e] + (((tot[e] + 255) >> 8) << 8);
            for (int s = lo + F.tid; s < hi; s += NTHREADS) { stok[s] = 0; sgate[s] = 0.f; WSP(float, WS_SA)[s] = 0.f; }
        }
    }
    LAS int* sl = tot + 32;
    const float* hs = WSP(float, WS_HS); const float* rinv = WSP(float, WS_RINV); unsigned char* xs = WSP(unsigned char, F_XS);
    if (F.blk == 0) {
        for (int e = 0; e < 8; ++e) {
            const int lo = tot[8 + e] + tot[e], hi = tot[8 + e] + (((tot[e] + 255) >> 8) << 8);
            for (int s = lo + F.wave; s < hi; s += 8)
                { unsigned zz = 0u; OPAQUE(zz); u32x4 z; z[0] = zz; z[1] = zz; z[2] = zz; z[3] = zz; *(u32x4*)(xs + ((size_t)s * D + F.lane * 16) * UESZ) = z; if (UESZ == 2) *(u32x4*)(xs + ((size_t)s * D + F.lane * 16) * UESZ + 16) = z; }
        }
    }
    for (int chunk = F.blk; chunk < NCHUNK; chunk += F.nblk) {
        __syncthreads();
        if (F.wave == 0) {
            const int row = chunk * 64 + F.lane; const bool valid = row < NV;
            const int e0 = valid ? tope[row * 2] : -1, e1 = valid ? tope[row * 2 + 1] : -1;
            const unsigned long long lt = (1ull << F.lane) - 1ull;
            int r0 = 0, r1 = 0;
#pragma unroll
            for (int x = 0; x < 8; ++x) {
                const unsigned long long m0 = __ballot(e0 == x), m1 = __ballot(e1 == x);
                const int before = __popcll(m0 & lt) + __popcll(m1 & lt);
                if (e0 == x) r0 = before;
                if (e1 == x) r1 = before;
            }
            int s0 = -1, s1 = -1;
            if (valid) {
                s0 = tot[8 + e0] + pre[chunk * 8 + e0] + r0; s1 = tot[8 + e1] + pre[chunk * 8 + e1] + r1;
                stok[s0] = row; sgate[s0] = topg[row * 2]; stok[s1] = row; sgate[s1] = topg[row * 2 + 1];
                tslot[row * 2] = s0; tslot[row * 2 + 1] = s1;
            }
            sl[F.lane * 2] = s0; sl[F.lane * 2 + 1] = s1;
        }
        __syncthreads();
        if constexpr (UMM == 3) {
            for (int ps = 0; ps < 2; ++ps) {
                const int rl = F.wave * 8 + ps * 4 + (F.lane >> 4), row = chunk * 64 + rl, l16 = F.lane & 15;
                const int s0 = sl[rl * 2], s1 = sl[rl * 2 + 1];
                const bool rv = s0 >= 0;
                f32x4 v[16]; float mx = 0.f;
#pragma unroll
                for (int i = 0; i < 16; ++i) v[i] = rv ? *(const f32x4*)(hs + (size_t)row * D + l16 * 64 + i * 4) : zero4();
#pragma unroll
                for (int i = 0; i < 16; ++i) mx = fmaxf(fmaxf(mx, fmaxf(fabsf(v[i][0]), fabsf(v[i][1]))), fmaxf(fabsf(v[i][2]), fabsf(v[i][3])));
#pragma unroll
                for (int o2 = 8; o2 >= 1; o2 >>= 1) mx = fmaxf(mx, shflx(mx, F.lane, o2));
                if (rv) {
                    const float qs = mx > 0.f ? 127.0f / mx : 0.f;
#pragma unroll
                    for (int q = 0; q < 4; ++q) {
                        u32x4 o;
#pragma unroll
                        for (int i = 0; i < 4; ++i) { const f32x4 w = v[q * 4 + i]; const int q0 = (int)rintf(w[0] * qs), q1 = (int)rintf(w[1] * qs), q2 = (int)rintf(w[2] * qs), q3 = (int)rintf(w[3] * qs);
                            o[i] = (unsigned)(q0 & 255) | ((unsigned)(q1 & 255) << 8) | ((unsigned)(q2 & 255) << 16) | ((unsigned)(q3 & 255) << 24); }
                        *(u32x4*)(xs + (size_t)s0 * D + l16 * 64 + q * 16) = o; *(u32x4*)(xs + (size_t)s1 * D + l16 * 64 + q * 16) = o;
                    }
                    if (l16 == 0) { const float sc = mx * rinv[row] * (1.0f / 127.0f); WSP(float, WS_SA)[s0] = sc; WSP(float, WS_SA)[s1] = sc; }
                }
            }
        } else
        for (int rr = 0; rr < 8; ++rr) {
            const int rl = F.wave * 8 + rr, row = chunk * 64 + rl;
            const int s0 = sl[rl * 2], s1 = sl[rl * 2 + 1];
            if (s0 >= 0) {
                const float ri = rinv[row];
                if constexpr (UMM == 3) {
                    f32x4 v[4]; float mx = 0.f;
#pragma unroll
                    for (int i = 0; i < 4; ++i) { v[i] = *(const f32x4*)(hs + (size_t)row * D + F.lane * 16 + i * 4); mx = fmaxf(fmaxf(mx, fmaxf(fabsf(v[i][0]), fabsf(v[i][1]))), fmaxf(fabsf(v[i][2]), fabsf(v[i][3]))); }
#pragma unroll
                    for (int o2 = 32; o2 >= 1; o2 >>= 1) mx = fmaxf(mx, shflx(mx, F.lane, o2));
                    const float qs = mx > 0.f ? 127.0f / mx : 0.f;
                    u32x4 o;
#pragma unroll
                    for (int i = 0; i < 4; ++i) { const int q0 = (int)rintf(v[i][0] * qs), q1 = (int)rintf(v[i][1] * qs), q2 = (int)rintf(v[i][2] * qs), q3 = (int)rintf(v[i][3] * qs);
                        o[i] = (unsigned)(q0 & 255) | ((unsigned)(q1 & 255) << 8) | ((unsigned)(q2 & 255) << 16) | ((unsigned)(q3 & 255) << 24); }
                    *(u32x4*)(xs + (size_t)s0 * D + F.lane * 16) = o; *(u32x4*)(xs + (size_t)s1 * D + F.lane * 16) = o;
                    if (F.lane == 0) { const float sc = mx * ri * (1.0f / 127.0f); WSP(float, WS_SA)[s0] = sc; WSP(float, WS_SA)[s1] = sc; }
                } else if constexpr (UESZ == 1) {
                    u32x4 o;
#pragma unroll
                    for (int i = 0; i < 4; ++i) { const f32x4 v = *(const f32x4*)(hs + (size_t)row * D + F.lane * 16 + i * 4) * ri; o[i] = pk4f8(v[0], v[1], v[2], v[3]); }
                    *(u32x4*)(xs + (size_t)s0 * D + F.lane * 16) = o; *(u32x4*)(xs + (size_t)s1 * D + F.lane * 16) = o;
                } else {
                    u32x4 o0, o1;
#pragma unroll
                    for (int i = 0; i < 2; ++i) { const f32x4 v = *(const f32x4*)(hs + (size_t)row * D + F.lane * 16 + i * 4) * ri, w = *(const f32x4*)(hs + (size_t)row * D + F.lane * 16 + 8 + i * 4) * ri;
                        o0[2 * i] = pk2(v[0], v[1]); o0[2 * i + 1] = pk2(v[2], v[3]); o1[2 * i] = pk2(w[0], w[1]); o1[2 * i + 1] = pk2(w[2], w[3]); }
                    bf16_t* x0 = (bf16_t*)xs + (size_t)s0 * D + F.lane * 16; bf16_t* x1 = (bf16_t*)xs + (size_t)s1 * D + F.lane * 16;
                    *(u32x4*)x0 = o0; *(u32x4*)(x0 + 8) = o1; *(u32x4*)x1 = o0; *(u32x4*)(x1 + 8) = o1;
                }
            }
        }
    }
}
__device__ __forceinline__ void moe_route_dispatch(const Frame& G, int layer) {
    const Frame F = local_frame(G);
    const int j = layer >> 1;
    constexpr int RSTR = 1040;
    LAS float* gw = (LAS float*)F.lds;
    LAS int* esel = (LAS int*)(gw + 8 * 1028);
    LAS float* eg = (LAS float*)(esel + 160);
    LAS float* esc = eg + 160;
    LAS int* sl = (LAS int*)(esc + 80);
    LAS unsigned char* rows = F.lds + 36864;
    const float* fn = F.in[25] + (size_t)layer * D; const float* rw = F.in[29] + (size_t)j * D * 8; const float* rb = F.in[30] + j * 8;
    unsigned* cntx = (unsigned*)(F.ws + WS_CNTX);
    const unsigned epoch = (unsigned)(layer + 1);
    const float* hs = WSP(float, WS_HS);
    __syncthreads();
    for (int i = F.tid; i < 8192; i += NTHREADS) gw[(i & 7) * 1028 + (i >> 3)] = fn[i >> 3] * rw[i];
    for (int ci = 0; ci < 2; ++ci) {
        const int chunk = F.blk + ci * F.nblk;
        if (chunk >= NCHUNK) break;
        __syncthreads();
        for (int ps = 0; ps < 2; ++ps) {
            const int rl = F.wave * 8 + ps * 4 + (F.lane >> 4), row = chunk * 64 + rl, l16 = F.lane & 15;
            const bool rv = row < NV;
            if (ci == 1 && rl >= 16) continue;
            float ss = 0.f, mx = 0.f, lg[8];
#pragma unroll
            for (int e = 0; e < 8; ++e) lg[e] = 0.f;
            f32x4 hv[16];
#pragma unroll
            for (int i = 0; i < 16; ++i) hv[i] = rv ? *(const f32x4*)(hs + (size_t)row * D + i * 64 + l16 * 4) : zero4();
#pragma unroll
            for (int i = 0; i < 16; ++i) {
                const int k = i * 64 + l16 * 4;
                const f32x4 v = hv[i];
                ss += v[0] * v[0] + v[1] * v[1] + v[2] * v[2] + v[3] * v[3];
                mx = fmaxf(fmaxf(mx, fmaxf(fabsf(v[0]), fabsf(v[1]))), fmaxf(fabsf(v[2]), fabsf(v[3])));
#pragma unroll
                for (int e = 0; e < 8; ++e) {
                    const f32x4 w = *(const LAS f32x4*)(gw + e * 1028 + k);
                    lg[e] += v[0] * w[0] + v[1] * w[1] + v[2] * w[2] + v[3] * w[3];
                }
            }
#pragma unroll
            for (int o = 8; o >= 1; o >>= 1) {
                ss += shflx(ss, F.lane, o); mx = fmaxf(mx, shflx(mx, F.lane, o));
#pragma unroll
                for (int e = 0; e < 8; ++e) lg[e] += shflx(lg[e], F.lane, o);
            }
            const int lrow = ci * 64 + rl;
            if (rv) {
                const float ri = rsqrtf(ss * (1.0f / D) + EPS);
                int e0 = 0; float l0 = -3.0e38f;
#pragma unroll
                for (int e = 0; e < 8; ++e) { lg[e] = lg[e] * ri + rb[e]; if (lg[e] > l0) { l0 = lg[e]; e0 = e; } }
                int e1 = 0; float l1 = -3.0e38f;
#pragma unroll
                for (int e = 0; e < 8; ++e) { if (e != e0 && lg[e] > l1) { l1 = lg[e]; e1 = e; } }
                const float g0 = 1.0f / (1.0f + __expf(l1 - l0)), g1 = 1.0f - g0;
                if (l16 == 0) { esel[lrow * 2] = e0; esel[lrow * 2 + 1] = e1; eg[lrow * 2] = g0; eg[lrow * 2 + 1] = g1; esc[lrow] = mx * ri * (1.0f / 127.0f); }
                const float qs = mx > 0.f ? 127.0f / mx : 0.f;
#pragma unroll
                for (int i = 0; i < 16; ++i) {
                    const f32x4 w = hv[i];
                    const int q0 = (int)rintf(w[0] * qs), q1 = (int)rintf(w[1] * qs), q2 = (int)rintf(w[2] * qs), q3 = (int)rintf(w[3] * qs);
                    *(LAS unsigned*)(rows + lrow * RSTR + i * 64 + l16 * 4) = (unsigned)(q0 & 255) | ((unsigned)(q1 & 255) << 8) | ((unsigned)(q2 & 255) << 16) | ((unsigned)(q3 & 255) << 24);
                }
            } else if (l16 == 0) { int m1 = -1; OPAQUE(m1); esel[lrow * 2] = m1; esel[lrow * 2 + 1] = m1; }
        }
        __syncthreads();
        if (F.tid < 8) {
            const int nrow = ci ? 16 : 64; int n = 0;
            for (int i = 0; i < nrow * 2; ++i) n += (esel[ci * 128 + i] == F.tid) ? 1 : 0;
            __hip_atomic_store(cntx + chunk * 8 + F.tid, (epoch << 16) | (unsigned)n, RLX_AGENT);
        }
    }
    __syncthreads();
    LAS int* pre = (LAS int*)F.lds;
    LAS int* tot = pre + NCHUNK * 8;
    {
        const int e = F.wave, l = F.lane;
        unsigned w0, w1, w2, w3, w4; unsigned sp = 0;
        for (;;) {
            w0 = __hip_atomic_load(cntx + (4 * l + 0) * 8 + e, RLX_AGENT); w1 = __hip_atomic_load(cntx + (4 * l + 1) * 8 + e, RLX_AGENT);
            w2 = __hip_atomic_load(cntx + (4 * l + 2) * 8 + e, RLX_AGENT); w3 = __hip_atomic_load(cntx + (4 * l + 3) * 8 + e, RLX_AGENT);
            w4 = (l == 63) ? __hip_atomic_load(cntx + 256 * 8 + e, RLX_AGENT) : (epoch << 16);
            const bool ok = ((w0 >> 16) == epoch) && ((w1 >> 16) == epoch) && ((w2 >> 16) == epoch) && ((w3 >> 16) == epoch) && ((w4 >> 16) == epoch);
            if (__all(ok)) break;
            __builtin_amdgcn_s_sleep(2);
            if (++sp > (1u << 22)) break;
        }
        const int v0 = (int)(w0 & 0xffffu), v1 = (int)(w1 & 0xffffu), v2 = (int)(w2 & 0xffffu), v3 = (int)(w3 & 0xffffu), v4 = (int)(w4 & 0xffffu);
        const int local = v0 + v1 + v2 + v3 + v4;
        int inc = local;
#pragma unroll
        for (int o = 1; o < 64; o <<= 1) { const int t = shfl_up_i(inc, l, o); if (l >= o) inc += t; }
        const int exc = inc - local;
        pre[(4 * l + 0) * 8 + e] = exc; pre[(4 * l + 1) * 8 + e] = exc + v0; pre[(4 * l + 2) * 8 + e] = exc + v0 + v1; pre[(4 * l + 3) * 8 + e] = exc + v0 + v1 + v2;
        if (l == 63) { pre[256 * 8 + e] = exc + v0 + v1 + v2 + v3; tot[e] = inc; }
    }
    __syncthreads();
    if (F.tid == 0) { int st = 0; for (int e = 0; e < 8; ++e) { tot[8 + e] = st; st += ((tot[e] + 255) >> 8) << 8; } tot[16] = st >> 8; }
    __syncthreads();
    int* stok = WSP(int, WS_STOK); float* sgate = WSP(float, WS_SGATE); int* tslot = WSP(int, WS_TSLOT); int* texp = WSP(int, WS_TEXP);
    unsigned char* xs = WSP(unsigned char, F_XS);
    if (F.blk == 0) {
        const int ntile = tot[16];
        for (int t = F.tid; t < ntile; t += NTHREADS) { int e = 0; for (int x = 1; x < 8; ++x) if (t * 256 >= tot[8 + x]) e = x; texp[t] = e; }
        if (F.tid == 0) texp[200] = ntile;
        for (int e = 0; e < 8; ++e) {
            const int lo = tot[8 + e] + tot[e], hi = tot[8 + e] + (((tot[e] + 255) >> 8) << 8);
            for (int s = lo + F.tid; s < hi; s += NTHREADS) { stok[s] = 0; sgate[s] = 0.f; WSP(float, WS_SA)[s] = 0.f; }
            for (int s = lo + F.wave; s < hi; s += 8) { unsigned zz = 0u; OPAQUE(zz); u32x4 z; z[0] = zz; z[1] = zz; z[2] = zz; z[3] = zz; *(u32x4*)(xs + (size_t)s * D + F.lane * 16) = z; }
        }
    }
    for (int ci = 0; ci < 2; ++ci) {
        const int chunk = F.blk + ci * F.nblk;
        if (chunk >= NCHUNK) break;
        __syncthreads();
        if (F.wave == 0) {
            const int row = chunk * 64 + F.lane; const bool valid = row < NV;
            const int e0 = valid ? esel[(ci * 64 + F.lane) * 2] : -1, e1 = valid ? esel[(ci * 64 + F.lane) * 2 + 1] : -1;
            const unsigned long long lt = (1ull << F.lane) - 1ull;
            int r0 = 0, r1 = 0;
#pragma unroll
            for (int x = 0; x < 8; ++x) {
                const unsigned long long m0 = __ballot(e0 == x), m1 = __ballot(e1 == x);
                const int before = __popcll(m0 & lt) + __popcll(m1 & lt);
                if (e0 == x) r0 = before;
                if (e1 == x) r1 = before;
            }
            int s0 = -1, s1 = -1;
            if (valid) {
                s0 = tot[8 + e0] + pre[chunk * 8 + e0] + r0; s1 = tot[8 + e1] + pre[chunk * 8 + e1] + r1;
                stok[s0] = row; sgate[s0] = eg[(ci * 64 + F.lane) * 2]; stok[s1] = row; sgate[s1] = eg[(ci * 64 + F.lane) * 2 + 1];
                tslot[row * 2] = s0; tslot[row * 2 + 1] = s1;
            }
            if (ci == 0 || F.lane < 16) { sl[(ci * 64 + F.lane) * 2] = s0; sl[(ci * 64 + F.lane) * 2 + 1] = s1; }
        }
        __syncthreads();
        for (int rr = 0; rr < 8; ++rr) {
            const int rl = F.wave * 8 + rr;
            if (ci == 1 && rl >= 16) break;
            const int lrow = ci * 64 + rl;
            const int s0 = sl[lrow * 2], s1 = sl[lrow * 2 + 1];
            if (s0 >= 0) {
                const u32x4 o = *(const LAS u32x4*)(rows + lrow * RSTR + F.lane * 16);
                *(u32x4*)(xs + (size_t)s0 * D + F.lane * 16) = o; *(u32x4*)(xs + (size_t)s1 * D + F.lane * 16) = o;
                if (F.lane == 0) { const float sc = esc[lrow]; WSP(float, WS_SA)[s0] = sc; WSP(float, WS_SA)[s1] = sc; }
            }
        }
    }
}
__device__ __forceinline__ void moe_combine(const Frame& G, int layer, int dry) {
    const Frame F = local_frame(G);
    float* hs = WSP(float, WS_HS); bf16_t* hsb = WSP(bf16_t, WS_HSB); float* rsp = WSP(float, WS_RSP);
    const bf16_t* ys = WSP(bf16_t, F_YS); const int* tslot = WSP(int, WS_TSLOT);
    const float* fn = F.in[34];
    for (int row = F.blk * 8 + F.wave; row < NV; row += F.nblk * 8) {
        const int s0 = tslot[row * 2], s1 = tslot[row * 2 + 1];
        f32x4 v[4]; float ss = 0.f;
#pragma unroll
        for (int i = 0; i < 4; ++i) {
            const int k = i * 256 + F.lane * 4;
            const f32x4 h = *(const f32x4*)(hs + (size_t)row * D + k);
            const f32x4 a = ld4bf(ys + (size_t)s0 * D + k), b = ld4bf(ys + (size_t)s1 * D + k);
            v[i] = (h + a) + b;
            if (!dry) { *(f32x4*)(hs + (size_t)row * D + k) = v[i];
            if (NEED_HSB) st4bf(hsb + (size_t)row * D + k, v[i]); }
            ss += v[i][0] * v[i][0] + v[i][1] * v[i][1] + v[i][2] * v[i][2] + v[i][3] * v[i][3];
        }
#pragma unroll
        for (int o = 32; o >= 1; o >>= 1) ss += shflx(ss, F.lane, o);
        if (NEED_HSB && !dry && F.lane < 16) rsp[(size_t)row * 16 + F.lane] = (F.lane == 0) ? ss : 0.f;
        if (WMM == 3 && !dry && layer + 1 < DEPTH) quant_row_store(v, ss, F.lane, WSP(unsigned char, WS_HSB8) + (size_t)row * D, WSP(float, WS_SA) + row);
        if (dry) asm volatile("" :: "v"(ss));
        if (!dry && layer == DEPTH - 1 && row < NTOK) {
            const float ri = rsqrtf(ss * (1.0f / D) + EPS);
#pragma unroll
            for (int i = 0; i < 4; ++i) {
                const int k = i * 256 + F.lane * 4;
                const f32x4 g = *(const f32x4*)(fn + k);
                f32x4 o; o[0] = v[i][0] * ri * g[0]; o[1] = v[i][1] * ri * g[1]; o[2] = v[i][2] * ri * g[2]; o[3] = v[i][3] * ri * g[3];
                *(f32x4*)(F.out + (size_t)row * D + k) = o;
            }
        }
    }
}

constexpr int LDS_BYTES = 147456;
constexpr int LDS_MISC = LDS_BYTES - 64;
constexpr int STEPS_PER_LAYER = 12;
constexpr int NSTEPS = 1 + DEPTH * STEPS_PER_LAYER;

__global__ void __launch_bounds__(NTHREADS, 2) fwd(Params P) {
    extern __shared__ __attribute__((aligned(16))) unsigned char lds_raw[];
    Frame F0;
    F0.lds = (LAS unsigned char*)lds_raw;
    F0.tid = threadIdx.x; F0.lane = F0.tid & 63; F0.wave = __builtin_amdgcn_readfirstlane(F0.tid >> 6);
    F0.blk = blockIdx.x; F0.nblk = gridDim.x; F0.ws = P.ws; F0.in = P.in; F0.out = P.out;
#if ONE_LAUNCH
    const int lo = 0, hi = NSTEPS;
#else
    const int lo = P.s_lo, hi = P.s_hi;
#endif
#if ONE_LAUNCH
    if (F0.tid < 16) ((LAS unsigned*)(F0.lds + LDS_MISC))[F0.tid] = 0u;
    __syncthreads();
    XcdBarrier bar = xcd_barrier_post((unsigned*)(F0.ws + WS_CTL), (volatile LAS unsigned*)(F0.lds + LDS_MISC));
#define GRID_SYNC() xcd_barrier(bar)
#else
#define GRID_SYNC() do { } while (0)
#endif
#if defined(ONLY)
#define PHSEL(n) (ONLY == (n))
#elif defined(PHMASK)
#define PHSEL(n) (((PHMASK) >> (n)) & 1)
#else
#define PHSEL(n) 1
#endif
#define IN(k) (lo <= (k) && (k) < hi)
#define SEAM(k) do { if (IN(k) && IN((k) + 1)) GRID_SYNC(); } while (0)

    for (int rp = 0; rp <= REPS(0); ++rp) if (PHSEL(0) && IN(0)) { const Frame F = local_frame(F0); prologue(F); SEAM(0); }
    for (int layer = 0; layer < DEPTH; ++layer) {
        const int sb = 1 + layer * STEPS_PER_LAYER;
#ifdef XBAR
        for (int xb = 0; xb < XBAR; ++xb) GRID_SYNC();
#endif
        const bool moe = (layer & 1) != 0; const int j = layer >> 1;
        for (int rp = 0; rp <= REPS(1); ++rp) if (PHSEL(1) && IN(sb + 0)) { const Frame F = local_frame(F0);

            EpiWin E{WSP(float, WS_RSP), WSP(bf16_t, T_US5), WSP(bf16_t, T_XLRU), WSP(bf16_t, T_GG), WSP(bf16_t, T_GATES), F.in[4] + (size_t)layer * 2048};
            dense_gemm<EpiWin, WMM>(F, WMM == 3 ? (const void*)WSP(unsigned char, WS_HSB8) : (const void*)WSP(bf16_t, WS_HSB), WSP(unsigned char, WS_WIN + layer * SZ_WIN), DIN, D, E, WSP(float, WS_SA), WSP(float, WS_CMAX) + CMAX_WIN + layer * DIN, nullptr, WIN_SPLIT ? WIN_NB : -1, WIN_SPLIT ? 1536 / 64 : -1);
            SEAM(sb + 0);
        }
        for (int rp = 0; rp <= REPS(2); ++rp) if (PHSEL(2) && IN(sb + 1)) { const Frame F = local_frame(F0);
            const int NS5 = (F.nblk * 120) / 256;
            if (F.blk < NS5) s5_phase_sp(F, layer, F.blk, NS5);
            else for (int u = F.blk - NS5; u < NPANEL * 8; u += F.nblk - NS5) { if (u < 8) lru_unit_sp(F, layer, 64, u); else lru_unit_sp(F, layer, (u - 8) >> 3, (u - 8) & 7); }
            SEAM(sb + 1);
        }
        for (int rp = 0; rp <= REPS(4); ++rp) if (PHSEL(4) && IN(sb + 3)) { const Frame F = local_frame(F0);
            APlain ap{WSP(bf16_t, T_YS5), 512}; BPlain bp{WSP(bf16_t, WS_WGLU + layer * SZ_WGLU)};
            EpiGlu E{WSP(bf16_t, T_YS5), F.in[14] + (size_t)layer * 512, WSP(bf16_t, T_SOLO)};
            if (!WIN_SPLIT) dense_gemm(F, ap.A, bp.Bt, 512, 512, E);
            else {
                const int nfirst = F.nblk >> 1;
                EpiWin EW{WSP(float, WS_RSP), WSP(bf16_t, T_US5), WSP(bf16_t, T_XLRU), WSP(bf16_t, T_GG), WSP(bf16_t, T_GATES), F.in[4] + (size_t)layer * 2048};
                const unsigned char* wa = WSP(unsigned char, WS_HSB8); const unsigned char* wb = WSP(unsigned char, WS_WIN + layer * SZ_WIN);
                const float* wsb = WSP(float, WS_CMAX) + CMAX_WIN + layer * DIN;
                if (F.blk < nfirst) {
                    { const Frame L = local_frame(F); pg8::DenseOrder S; S.init(ap.A, bp.Bt, NTOK, 512, 512, 2, nfirst, L.blk);
                      pg8::gemm_phase<EpiGlu, pg8::DenseOrder, 2>(L.lds, 512, 512, 512, S, E, L.tid); }
                    for (int v = F.blk; v < 8 + (DIN - 1536) / 64; v += nfirst) {
                        const Frame R = local_frame(F);
                        if (v < 8) rider_gemm<EpiGlu, false, 2>(R, ap.A, 512, bp.Bt, 512, 512, E, nullptr, nullptr, nullptr, nullptr, v, v + 1, 0);
                        else rider_gemm<EpiWin, false, WMM>(R, (const bf16_t*)wa, D, (const bf16_t*)wb, DIN, D, EW, nullptr, nullptr, WSP(float, WS_SA), wsb, 1536 / 64 + v - 8, 1536 / 64 + v - 7, 0);
                    }
                } else {
                    const Frame L = local_frame(F); pg8::DenseOrder S; S.init(wa, wb, NTOK, DIN - WIN_NB, D, 1, L.nblk - nfirst, L.blk - nfirst, WIN_NB / 256); S.SB = wsb;
                    pg8::gemm_phase<EpiWin, pg8::DenseOrder, WMM>(L.lds, D, D, D, S, EW, L.tid, WSP(float, WS_SA));
                }
            }
            SEAM(sb + 3);
        }
        for (int rp = 0; rp <= REPS(5); ++rp) if (PHSEL(5) && IN(sb + 4)) { const Frame F = local_frame(F0);
            proj_gemm(F, WSP(bf16_t, T_SOLO), WSP(bf16_t, WS_WPROJ + layer * SZ_WPROJ), WSP(bf16_t, T_GATES), WSP(bf16_t, T_Y), (layer >= WOUT_F8_FROM) ? 1 : 0);
            SEAM(sb + 4);
        }
        for (int rp = 0; rp <= REPS(6); ++rp) if (PHSEL(6) && IN(sb + 5)) { const Frame F = local_frame(F0);
            EpiRes E{WSP(float, WS_HS), WSP(bf16_t, WS_HSB), WSP(float, WS_RSP), (rp < REPS(6)) ? 1 : 0, (moe || UMM != 1) ? nullptr : WSP(unsigned char, WS_HSB8), (layer >= WOUT_F8_FROM) ? FSC * (1.0f / YSC) : 1.0f, (SKIP_HS0 && layer == 0) ? F.in[0] : WSP(float, WS_HS)};
            EpiRes ER = E; if (SKIP_HS0 && layer == 0) ER.res = F.in[1] - (size_t)NTOK * D;
            unsigned* pc = (unsigned*)(F.ws + WS_PCNT) + (size_t)(layer * 2 + 0) * 65 * 16;
            if (FUSE_POST && UMM == 3) { if (moe) res_gemm<2, 2>(F, WSP(bf16_t, T_Y), WSP(bf16_t, WS_WOUT + layer * SZ_WPROJ), D, E, layer, pc); else res_gemm<2, 1>(F, WSP(bf16_t, T_Y), WSP(bf16_t, WS_WOUT + layer * SZ_WPROJ), D, E, layer, pc); }
            else if (WOUT_F8_FROM > 0 && layer < WOUT_F8_FROM) dense_gemm(F, WSP(bf16_t, T_Y), WSP(bf16_t, WS_WOUT + layer * SZ_WPROJ), D, D, E);
            else dense_gemm<EpiRes, 1>(F, WSP(unsigned char, T_Y), WSP(unsigned char, WS_WOUT + layer * SZ_WPROJ), D, D, E, nullptr, nullptr, &ER);
            SEAM(sb + 5);
        }
        if (!moe) {
            if (UMM == 3 && !FUSE_POST) { for (int rp = 0; rp <= REPS(14); ++rp) { const Frame F = local_frame(F0); qnorm_rows(F); GRID_SYNC(); } }
            for (int rp = 0; rp <= REPS(7); ++rp) if (PHSEL(7) && IN(sb + 6)) { const Frame F = local_frame(F0);
                EpiUp E{WSP(float, WS_RSP), WSP(unsigned char, F_ACT), (rp < REPS(7)) ? 1 : 0, ((j == 0 ? DESZ_D : DESZ_D2) == 1) ? 1 : 0};
                dense_gemm<EpiUp, UMM>(F, UESZ == 1 ? WSP(unsigned char, WS_HSB8) : WSP(unsigned char, WS_HSB), WSP(unsigned char, WS_DGU + j * SZ_DGU), 2 * DFF, D, E, WSP(float, WS_SA), WSP(float, WS_CMAX) + j * 2 * DFF);
                SEAM(sb + 6);
            }
            for (int rp = 0; rp <= REPS(8); ++rp) if (PHSEL(8) && IN(sb + 7)) { const Frame F = local_frame(F0);

                EpiRes E{WSP(float, WS_HS), WSP(bf16_t, WS_HSB), WSP(float, WS_RSP), (rp < REPS(8)) ? 1 : 0, nullptr, ((j == 0 ? DESZ_D : DESZ_D2) == 1) ? FSC : 1.0f, WSP(float, WS_HS)};
                unsigned* pc = (unsigned*)(F.ws + WS_PCNT) + (size_t)(layer * 2 + 1) * 65 * 16;
                if (FUSE_POST && WMM == 3 && layer + 1 < DEPTH) res_gemm<DESZ_D, 1>(F, WSP(unsigned char, F_ACT), WSP(unsigned char, WS_DDN + j * SZ_DDN), DFF, E, layer, pc);
                else if (j == 0) dense_gemm<EpiRes, DESZ_D>(F, WSP(unsigned char, F_ACT), WSP(unsigned char, WS_DDN + j * SZ_DDN), D, DFF, E);
                else dense_gemm<EpiRes, DESZ_D2>(F, WSP(unsigned char, F_ACT), WSP(unsigned char, WS_DDN + j * SZ_DDN), D, DFF, E);
                if (layer + 1 < DEPTH) SEAM(sb + 7);
            }
            if (WMM == 3 && !FUSE_POST && layer + 1 < DEPTH) { const Frame F = local_frame(F0); qnorm_rows(F); GRID_SYNC(); }
        } else {
            if (FUSE_RD && UMM == 3 && (int)gridDim.x >= NCHUNK - 1) {
                if (PHSEL(9) && IN(sb + 6)) { const Frame F = local_frame(F0); moe_route_dispatch(F, layer); SEAM(sb + 7); }
            } else {
            for (int rp = 0; rp <= REPS(9); ++rp) if (PHSEL(9) && IN(sb + 6) && !(FUSE_POST && UMM == 3)) { const Frame F = local_frame(F0); moe_router(F, layer, -1, NCHUNK); SEAM(sb + 6); }
            for (int rp = 0; rp <= REPS(10); ++rp) if (PHSEL(10) && IN(sb + 7)) { const Frame F = local_frame(F0); moe_dispatch(F); SEAM(sb + 7); }
            }
            for (int rp = 0; rp <= REPS(11); ++rp) if (PHSEL(11) && IN(sb + 8)) { const Frame F = local_frame(F0);
                const int nslot = __builtin_amdgcn_readfirstlane(WSP(int, WS_TEXP)[200]) * 256;
                EpiMoeUp E{WSP(unsigned char, F_ACT)};
                const Frame L = local_frame(F);
                pg8::GroupedOrder S{(const char*)WSP(bf16_t, F_XS), (const char*)WSP(bf16_t, WS_MGU + (size_t)j * NEXP * SZ_MGU), WSP(int, WS_TEXP), nullptr, SZ_MGU, (size_t)256 * D * UESZ, (size_t)256 * D * UESZ,
                                    nslot >> 8, (2 * EFF) / 256, (nslot >> 8) * ((2 * EFF) / 256), L.nblk, L.blk, WSP(float, WS_CMAX) + CMAX_MOE + j * NEXP * 2 * EFF, 2 * EFF};
                pg8::gemm_phase<EpiMoeUp, pg8::GroupedOrder, UMM>(L.lds, D, D, D, S, E, L.tid, WSP(float, WS_SA));
                SEAM(sb + 8);
            }
            for (int rp = 0; rp <= REPS(12); ++rp) if (PHSEL(12) && IN(sb + 9)) { const Frame F = local_frame(F0);
                const int nslot = __builtin_amdgcn_readfirstlane(WSP(int, WS_TEXP)[200]) * 256;
                EpiMoeDown E{WSP(float, WS_SGATE), WSP(bf16_t, F_YS)};
                const Frame L = local_frame(F);
                pg8::GroupedOrder S{(const char*)WSP(bf16_t, F_ACT), (const char*)WSP(bf16_t, WS_MDN + (size_t)j * NEXP * SZ_MDN), WSP(int, WS_TEXP), nullptr, SZ_MDN, (size_t)256 * EFF * DESZ_M, (size_t)256 * EFF * DESZ_M,
                                    nslot >> 8, D / 256, (nslot >> 8) * (D / 256), L.nblk, L.blk, nullptr, 0};
                pg8::gemm_phase<EpiMoeDown, pg8::GroupedOrder, DESZ_M>(L.lds, EFF, EFF, EFF, S, E, L.tid);
                SEAM(sb + 9);
            }
            for (int rp = 0; rp <= REPS(13); ++rp) if (PHSEL(13) && IN(sb + 10)) { const Frame F = local_frame(F0); moe_combine(F, layer, (rp < REPS(13)) ? 1 : 0); if (layer + 1 < DEPTH) SEAM(sb + 10); }
        }
    }
}

static bool step_exists(int s) {
    if (s == 0) return true;
    const int layer = (s - 1) / STEPS_PER_LAYER, ls = (s - 1) % STEPS_PER_LAYER;
    if (layer & 1) return ls <= 10;
    return ls <= 7;
}
extern "C" void kernel_launch(void* const* d_in, const int* in_sizes, int n_in, void* d_out, int out_size, void* d_ws, size_t ws_size, hipStream_t stream) {
    static int grid = 0;
    if (grid == 0) {
        if (n_in != 35 || out_size != NTOK * D || ws_size < WS_END) { fprintf(stderr, "kernel_launch: unexpected problem (n_in %d out %d ws %zu need %zu)\n", n_in, out_size, ws_size, (size_t)WS_END); grid = -1; return; }
        int dev = 0, cus = 0;
        if (hipGetDevice(&dev) != hipSuccess || hipDeviceGetAttribute(&cus, hipDeviceAttributeMultiprocessorCount, dev) != hipSuccess) { grid = -1; return; }
        if (hipFuncSetAttribute((const void*)fwd, hipFuncAttributeMaxDynamicSharedMemorySize, LDS_BYTES) != hipSuccess) { fprintf(stderr, "kernel_launch: hipFuncSetAttribute failed\n"); grid = -1; return; }
        int per_cu = 0;
        if (hipOccupancyMaxActiveBlocksPerMultiprocessor(&per_cu, (const void*)fwd, NTHREADS, LDS_BYTES) != hipSuccess || per_cu < 1) { fprintf(stderr, "kernel_launch: occupancy query says %d\n", per_cu); }
        (void)hipGetLastError();
        grid = cus;
    }
    if (grid < 0) return;
    (void)hipMemsetAsync((char*)d_ws + WS_CTL, 0, CTL_BYTES, stream);
    Params p;
    memset(&p, 0, sizeof(p));
    for (int i = 0; i < 35; ++i) p.in[i] = (const float*)d_in[i];
    p.out = (float*)d_out; p.ws = (unsigned char*)d_ws;
#if ONE_LAUNCH
    p.s_lo = 0; p.s_hi = NSTEPS;
    hipLaunchKernelGGL(fwd, dim3(grid), dim3(NTHREADS), LDS_BYTES, stream, p);
#else
    for (int s = 0; s < NSTEPS; ++s) {
        if (!step_exists(s)) continue;
        p.s_lo = s; p.s_hi = s + 1;
        hipLaunchKernelGGL(fwd, dim3(grid), dim3(NTHREADS), LDS_BYTES, stream, p);
    }
#endif
}
```

```cpp
#include <hip/hip_runtime.h>
#include <cstdio>
#include <cstdint>
#include <cstring>

#ifndef REPMASK
#define REPMASK 0
#endif
#define REPS(n) (((REPMASK) >> (n)) & 1)
#ifndef ONE_LAUNCH
#define ONE_LAUNCH 1
#endif

typedef unsigned short bf16_t;
typedef short bf16x8 __attribute__((ext_vector_type(8)));
typedef float f32x4 __attribute__((ext_vector_type(4)));
typedef float f32x2 __attribute__((ext_vector_type(2)));
typedef unsigned u32x2 __attribute__((ext_vector_type(2)));
typedef unsigned u32x4 __attribute__((ext_vector_type(4)));
#define LAS __attribute__((address_space(3)))

constexpr int D = 1024, NTOK = 16384, SEQ = 8192, NMETA = 16, NV = NTOK + NMETA, MP = 16640;
constexpr int DIN = 3584, S5W = 512, LRUW = 512, NG = 32, NP = 64, NH = 16;
constexpr int DFF = 3072, EFF = 1536, NEXP = 8, DEPTH = 4;
constexpr int NPANEL = 65;
constexpr int MAXSLOT = 137 * 256;
constexpr int NCHUNK = 257;
constexpr float EPS = 1e-6f;
constexpr int NTHREADS = 512;
constexpr int LDS_MISC_OFF = 147456 - 64;

constexpr size_t al256(size_t x) { return (x + 255) & ~(size_t)255; }
constexpr size_t WS_CTL = 0;
constexpr int WMM = 3;
constexpr size_t WS_LFLAG = 319488;
constexpr size_t WS_SFLAG = WS_LFLAG + (size_t)NPANEL * 8 * 64;
constexpr size_t WS_PCNT = 491520;
constexpr size_t WS_CNTX = 491520 + (size_t)DEPTH * 2 * 65 * 64;
constexpr size_t CTL_BYTES = WS_CNTX + 8448;
constexpr bool FUSE_POST = false;
constexpr int WOUT_F8_FROM = 0;
constexpr float YSC = 16.0f;
constexpr bool SKIP_HS0 = true;
constexpr bool WIN_SPLIT = (WMM == 3);
constexpr int WIN_NB = 3072;
constexpr bool SKIP_DEAD_META = true;
constexpr bool FUSE_RD = true;
static_assert(WS_SFLAG + (size_t)NPANEL * 32 * 64 <= WS_PCNT, "control region");
constexpr size_t WS_CMAX = 16384;
constexpr int CMAX_MOE = 2 * 2 * DFF;
constexpr int CMAX_WIN = CMAX_MOE + 2 * NEXP * 2 * EFF;
constexpr size_t WS_WIN = WS_CTL + CTL_BYTES;
constexpr size_t SZ_WIN = (size_t)DIN * D * (WMM == 2 ? 2 : 1);
constexpr size_t WS_WGLU = WS_WIN + 4 * SZ_WIN;
constexpr size_t SZ_WGLU = (size_t)512 * 512 * 2;
constexpr size_t WS_WPROJ = WS_WGLU + 4 * SZ_WGLU;
constexpr size_t SZ_WPROJ = (size_t)D * D * 2;
constexpr size_t WS_WOUT = WS_WPROJ + 4 * SZ_WPROJ;
constexpr size_t WS_DGU = WS_WOUT + 4 * SZ_WPROJ;
constexpr float FSC = 1.0f / 32.0f;
constexpr int UMM = 3;
constexpr int UESZ = (UMM == 2) ? 2 : 1;
constexpr bool NEED_HSB = (WMM == 2) || (UMM == 2);

constexpr int DESZ_D2 = 1;
constexpr int DESZ_D = 2;
constexpr int DESZ_M = 1;
constexpr int DESZ_MAX = 2;
constexpr size_t SZ_DGU = (size_t)2 * DFF * D * UESZ;
constexpr size_t WS_DDN = WS_DGU + 2 * SZ_DGU;
constexpr size_t SZ_DDN = (size_t)D * DFF * 2;
constexpr size_t WS_MGU = WS_DDN + 2 * SZ_DDN;
constexpr size_t SZ_MGU = (size_t)2 * EFF * D * UESZ;
constexpr size_t WS_MDN = WS_MGU + 16 * SZ_MGU;
constexpr size_t SZ_MDN = (size_t)D * EFF * DESZ_M;
constexpr size_t WS_S5T = WS_MDN + 16 * SZ_MDN;
constexpr size_t SZ_S5T1 = (size_t)128 * 128 * 2;
constexpr size_t WS_W8 = WS_S5T + (size_t)4 * 32 * 3 * SZ_S5T1;
constexpr size_t WS_W256 = WS_W8 + (size_t)4 * 32 * 64 * 8;
constexpr size_t WS_LRUW = WS_W256 + (size_t)4 * 32 * 64 * 8;
constexpr size_t WS_HS = WS_LRUW + (size_t)4 * 8 * 2 * 4096 * 2;
constexpr size_t WS_HSB = WS_HS + (size_t)MP * D * 4;
constexpr size_t WS_HSB8 = WS_HSB + (size_t)MP * D * 2;
constexpr size_t WS_SA = WS_HSB8 + (UESZ == 1 ? (size_t)MP * D : 0);
constexpr size_t WS_RSP = WS_SA + (size_t)MAXSLOT * 4;
constexpr size_t WS_SPAN = WS_RSP + (size_t)MP * 16 * 4;
constexpr size_t WS_APAN = WS_SPAN + (size_t)NPANEL * 32 * 64 * 8;
constexpr size_t WS_HPAN = WS_APAN + (size_t)NPANEL * 512 * 4;
constexpr size_t WS_TOPE = al256(WS_HPAN + (size_t)NPANEL * 512 * 4);
constexpr size_t WS_TOPG = WS_TOPE + (size_t)MP * 2 * 4;
constexpr size_t WS_RINV = WS_TOPG + (size_t)MP * 2 * 4;
constexpr size_t WS_CNT = WS_RINV + (size_t)MP * 4;
constexpr size_t WS_STOK = al256(WS_CNT + (size_t)NCHUNK * 8 * 4);
constexpr size_t WS_SGATE = WS_STOK + (size_t)MAXSLOT * 4;
constexpr size_t WS_TSLOT = WS_SGATE + (size_t)MAXSLOT * 4;
constexpr size_t WS_TEXP = WS_TSLOT + (size_t)MP * 2 * 4;
constexpr size_t WS_REG = al256(WS_TEXP + 1024);
constexpr size_t T_US5 = WS_REG;
constexpr size_t T_XLRU = T_US5 + (size_t)MP * 512 * 2;
constexpr size_t T_Y = T_US5;
constexpr size_t T_GG = T_XLRU + (size_t)MP * 512 * 2;
constexpr size_t T_GATES = T_GG + (size_t)MP * 512 * 2;
constexpr size_t T_YS5 = T_GATES + (size_t)MP * 2048 * 2;
constexpr size_t T_SOLO = T_YS5 + (size_t)MP * 512 * 2;
constexpr size_t T_END = T_SOLO + (size_t)MP * D * 2;
constexpr size_t F_ACT = WS_REG;
constexpr size_t SZ_ACT = ((size_t)MAXSLOT * EFF > (size_t)MP * DFF ? (size_t)MAXSLOT * EFF : (size_t)MP * DFF) * DESZ_MAX;
constexpr size_t F_YS = F_ACT + SZ_ACT;
constexpr size_t F_XS = F_YS;
constexpr size_t F_END = F_YS + (size_t)MAXSLOT * D * 2;
constexpr size_t WS_END = (T_END > F_END ? T_END : F_END);
static_assert(WS_END <= 544000000ull, "workspace budget");

struct Params {
    const float* in[35];
    float* out;
    unsigned char* ws;
    int s_lo, s_hi;
};

__device__ __forceinline__ f32x4 zero4() { float z = 0.f; asm volatile("" : "+v"(z)); f32x4 r; r[0] = z; r[1] = z; r[2] = z; r[3] = z; return r; }
__device__ __forceinline__ float bf2f(bf16_t b) { return __uint_as_float(((unsigned)b) << 16); }
__device__ __forceinline__ bf16_t f2bf(float f) { unsigned u = __float_as_uint(f); u += 0x7FFFu + ((u >> 16) & 1u); return (bf16_t)(u >> 16); }
__device__ __forceinline__ unsigned pk2(float lo, float hi) { return (unsigned)f2bf(lo) | ((unsigned)f2bf(hi) << 16); }
__device__ __forceinline__ float sat8(float x) { return __builtin_fminf(__builtin_fmaxf(x, -448.0f), 448.0f); }
__device__ __forceinline__ unsigned pk4f8(float a, float b, float c, float d) { int p = __builtin_amdgcn_cvt_pk_fp8_f32(sat8(a), sat8(b), 0, false); p = __builtin_amdgcn_cvt_pk_fp8_f32(sat8(c), sat8(d), p, true); return (unsigned)p; }
__device__ __forceinline__ float sigmoidf_(float x) { return __builtin_amdgcn_rcpf(1.0f + __expf(-x)); }
__device__ __forceinline__ float gelu_tanh(float x) {
    const float u = 0.7978845608028654f * (x + 0.044715f * x * x * x);
    const float t = 1.0f - 2.0f * __builtin_amdgcn_rcpf(1.0f + __expf(2.0f * u));
    return 0.5f * x * (1.0f + t);
}
__device__ __forceinline__ float silu_(float x) { return x * __builtin_amdgcn_rcpf(1.0f + __expf(-x)); }
__device__ __forceinline__ float one_minus_exp(float x) { const float s = -x * (1.0f + x * (0.5f + x * (0.16666667f + x * (0.041666668f + x * 0.0083333338f)))); return (x > -0.25f) ? s : 1.0f - __expf(x); }

__device__ __forceinline__ int lane_id_now() { int l; asm volatile("v_mbcnt_lo_u32_b32 %0, -1, 0\n\tv_mbcnt_hi_u32_b32 %0, -1, %0" : "=v"(l)); return l; }
#define XB_TMO      128
#define XB_XCNT(j)  (256  + 64 * (j))
#define XB_XSUB(j)  (1280 + 64 * (j))
#define XB_XGEN(j)  (2304 + 64 * (j))
#define XB_TOP      3328
#define XB_TOPGEN   3392
#define XCD_BAR_WORDS 3456
#define XB_SPIN_CAP (1u << 18)
__device__ __forceinline__ unsigned xb_ld(unsigned* p)              { return __hip_atomic_load(p, __ATOMIC_RELAXED, __HIP_MEMORY_SCOPE_AGENT); }
__device__ __forceinline__ unsigned xb_add(unsigned* p, unsigned v) { return __hip_atomic_fetch_add(p, v, __ATOMIC_RELAXED, __HIP_MEMORY_SCOPE_AGENT); }
__device__ __forceinline__ unsigned xb_xcc_id() { return (unsigned)__builtin_amdgcn_s_getreg((3 << 11) | 20) & 0xFu; }
#define XB_SPIN(cond, bar) do { unsigned _sp = 0; while (cond) { __builtin_amdgcn_s_sleep(1); \
    if ((++_sp & 255u) == 0u) { if (xb_ld(&(bar)[XB_TMO])) break; if (_sp > XB_SPIN_CAP) { atomicAdd(&(bar)[XB_TMO], 1u); break; } } } } while (0)
struct XcdBarrier { unsigned* bar; unsigned x; volatile LAS unsigned* st; unsigned wave; };
__device__ __forceinline__ XcdBarrier xcd_barrier_post(unsigned* bar, volatile LAS unsigned* st) {
    XcdBarrier b; b.bar = bar; b.x = xb_xcc_id(); b.st = st; b.wave = (unsigned)__builtin_amdgcn_readfirstlane((int)(threadIdx.x >> 6));
    if (threadIdx.x == 0) (void)xb_add(&bar[XB_XCNT(b.x)], 1u);
    return b;
}
__device__ __forceinline__ void xcd_barrier_complete(unsigned* bar, unsigned x, unsigned& nloc, unsigned& nx) {
    const unsigned G = gridDim.x * gridDim.y * gridDim.z;
    unsigned sum, cnt, mine, sp = 0u;
    for (;;) {
        sum = 0u; cnt = 0u; mine = 0u;
#pragma unroll
        for (unsigned j = 0; j < 16; ++j) { const unsigned c = xb_ld(&bar[XB_XCNT(j)]); sum += c; cnt += (c > 0u) ? 1u : 0u; mine = (j == x) ? c : mine; }
        if (sum == G) break;
        __builtin_amdgcn_s_sleep(1);
        if ((++sp & 255u) == 0u) { if (xb_ld(&bar[XB_TMO])) break; if (sp > XB_SPIN_CAP) { atomicAdd(&bar[XB_TMO], 1u); break; } }
    }
    nloc = mine > 0u ? mine : 1u; nx = cnt > 0u ? cnt : 1u;
}
__device__ __forceinline__ void xcd_barrier(const XcdBarrier& b) {
    asm volatile("s_waitcnt vmcnt(0)" ::: "memory");
    __syncthreads();
    unsigned tx = b.wave * 64u + (unsigned)lane_id_now();
    if (tx == 0) {
        unsigned* bar = b.bar;
        __builtin_amdgcn_s_waitcnt(0);
        unsigned nloc = b.st[0], nx = b.st[1];
        if (nloc == 0u) { xcd_barrier_complete(bar, b.x, nloc, nx); b.st[0] = nloc; b.st[1] = nx; }
        const unsigned old = xb_add(&bar[XB_XSUB(b.x)], 1u);
        const unsigned gen = old / nloc;
        if (old + 1u == (gen + 1u) * nloc) {
            __builtin_amdgcn_fence(__ATOMIC_RELEASE, "agent");
            asm volatile("s_waitcnt vmcnt(0)" ::: "memory");
            const unsigned og = xb_add(&bar[XB_TOP], 1u);
            const unsigned tg = og / nx;
            if (og + 1u == (tg + 1u) * nx) xb_add(&bar[XB_TOPGEN], 1u);
            else XB_SPIN(xb_ld(&bar[XB_TOPGEN]) == tg, bar);
            __builtin_amdgcn_fence(__ATOMIC_ACQUIRE, "agent");
            xb_add(&bar[XB_XGEN(b.x)], 1u);
            asm volatile("s_waitcnt vmcnt(0)" ::: "memory");
        } else {
            XB_SPIN(xb_ld(&bar[XB_XGEN(b.x)]) == gen, bar);
            __builtin_amdgcn_fence(__ATOMIC_ACQUIRE, "agent");
            asm volatile("s_waitcnt vmcnt(0)" ::: "memory");
        }
    }
    __syncthreads();
}

#define GAS __attribute__((address_space(1)))
struct Frame {
    LAS unsigned char* lds;
    int tid, lane, wave, blk, nblk;
    GAS unsigned char* ws;
    const float* const* in;
    float* out;
};
#define WSP(T, off) ((T*)(GAS T*)(F.ws + (off)))
#define OPAQUE(x) asm volatile("" : "+v"(x))
__device__ __forceinline__ float shflx(float v, int lane, int mask) { return __int_as_float(__builtin_amdgcn_ds_bpermute((lane ^ mask) << 2, __float_as_int(v))); }
__device__ __forceinline__ int shfl_up_i(int v, int lane, int d) { return __builtin_amdgcn_ds_bpermute(((lane >= d) ? lane - d : lane) << 2, v); }
__device__ __forceinline__ Frame local_frame(const Frame& G) { Frame F = G; int t = G.wave * 64 + lane_id_now(); F.tid = t; F.lane = t & 63; GAS unsigned char* w = G.ws; asm volatile("" : "+s"(w)); F.ws = w; int bk = G.blk, nb = G.nblk; asm volatile("" : "+s"(bk), "+s"(nb)); F.blk = bk; F.nblk = nb; unsigned lb = (unsigned)(size_t)G.lds; asm volatile("" : "+s"(lb)); F.lds = (LAS unsigned char*)(size_t)lb; return F; }

constexpr bool PERM16 = (WMM == 3) && (UMM == 3);
__host__ __device__ __forceinline__ int slot_win(int c) { const int cc = c & 255; return (c & ~255) + ((cc >> 3) & 1) * 128 + (cc >> 6) * 32 + ((cc >> 2) & 1) * 16 + ((cc >> 4) & 3) * 4 + (cc & 3); }
__host__ __device__ __forceinline__ int slot_gu(int a, int n) { const int aa = a & 127; return (a >> 7) * 256 + ((aa >> 2) & 1) * 128 + (aa >> 5) * 32 + n * 16 + ((aa >> 3) & 3) * 4 + (aa & 3); }

__device__ __forceinline__ void tr_convert(const Frame& F, const float* src, int K, int N, bf16_t* dst, int ldd, int kofs, const float* scale, int mode, int radd, int& rot, int f8 = 0, float* cmax = nullptr) {
    LAS float* tile = (LAS float*)F.lds;
    const int tn = N / 128, ntile = (K / 64) * tn;
    const int tid = F.tid;
    int t = (F.blk + F.nblk - (rot % F.nblk)) % F.nblk;
    rot += ntile;
    if (t >= ntile) return;
    f32x4 cur[4], nxt[4];
#define TR_LOAD(dst_, tt) do { const int _k0 = ((tt) / tn) * 64, _n0 = ((tt) % tn) * 128; _Pragma("unroll") for (int _i = 0; _i < 4; ++_i) { const int _idx = tid + _i * NTHREADS; \
        dst_[_i] = __builtin_nontemporal_load((const f32x4*)(src + (size_t)(_k0 + (_idx >> 5)) * N + _n0 + (_idx & 31) * 4)); } } while (0)
    TR_LOAD(cur, t);
    for (; t < ntile; t += F.nblk) {
        const int k0 = (t / tn) * 64, n0 = (t % tn) * 128;
        const bool more = t + F.nblk < ntile;
        if (more) TR_LOAD(nxt, t + F.nblk);
        __syncthreads();
#pragma unroll
        for (int i = 0; i < 4; ++i) {
            const int idx = tid + i * NTHREADS, kk = idx >> 5, n4 = (idx & 31) * 4;
            const float s = scale ? scale[k0 + kk] : 1.0f;
            tile[kk * 129 + n4 + 0] = cur[i][0] * s; tile[kk * 129 + n4 + 1] = cur[i][1] * s; tile[kk * 129 + n4 + 2] = cur[i][2] * s; tile[kk * 129 + n4 + 3] = cur[i][3] * s;
        }
        __syncthreads();
        {
            const int nn = tid >> 2, kq = (tid & 3) * 16;
            const int n = n0 + nn;
            const int r = mode == 2 ? slot_win(n) : (mode ? (((n >> 4) << 5) + (n & 15) + radd) : n);
            if (f8 == 2) {
                float mx = 0.f;
#pragma unroll
                for (int j = 0; j < 16; ++j) mx = fmaxf(mx, fabsf(tile[(kq + j) * 129 + nn]));
                mx = fmaxf(mx, shflx(mx, F.lane, 1)); mx = fmaxf(mx, shflx(mx, F.lane, 2));
                if ((tid & 3) == 0) atomicMax((unsigned*)cmax + r, __float_as_uint(mx));
            } else if (f8 == 3) {
                const float cm = cmax[r], qs = cm > 0.f ? 127.0f / cm : 0.f;
                u32x4 o;
#pragma unroll
                for (int j = 0; j < 4; ++j) {
                    const int q0 = (int)rintf(tile[(kq + 4 * j) * 129 + nn] * qs), q1 = (int)rintf(tile[(kq + 4 * j + 1) * 129 + nn] * qs), q2 = (int)rintf(tile[(kq + 4 * j + 2) * 129 + nn] * qs), q3 = (int)rintf(tile[(kq + 4 * j + 3) * 129 + nn] * qs);
                    o[j] = (unsigned)(q0 & 255) | ((unsigned)(q1 & 255) << 8) | ((unsigned)(q2 & 255) << 16) | ((unsigned)(q3 & 255) << 24);
                }
                *(u32x4*)((unsigned char*)dst + (size_t)r * ldd + kofs + k0 + kq) = o;
            } else if (f8) {
                u32x4 o;
#pragma unroll
                for (int j = 0; j < 4; ++j) o[j] = pk4f8(32.f * tile[(kq + 4 * j) * 129 + nn], 32.f * tile[(kq + 4 * j + 1) * 129 + nn], 32.f * tile[(kq + 4 * j + 2) * 129 + nn], 32.f * tile[(kq + 4 * j + 3) * 129 + nn]);
                *(u32x4*)((unsigned char*)dst + (size_t)r * ldd + kofs + k0 + kq) = o;
            } else {
                u32x4 o0, o1;
#pragma unroll
                for (int j = 0; j < 4; ++j) { o0[j] = pk2(tile[(kq + 2 * j) * 129 + nn], tile[(kq + 2 * j + 1) * 129 + nn]); o1[j] = pk2(tile[(kq + 8 + 2 * j) * 129 + nn], tile[(kq + 8 + 2 * j + 1) * 129 + nn]); }
                bf16_t* dp = dst + (size_t)r * ldd + kofs + k0 + kq;
                *(u32x4*)dp = o0; *(u32x4*)(dp + 8) = o1;
            }
        }
        if (more) {
#pragma unroll
            for (int i = 0; i < 4; ++i) cur[i] = nxt[i];
        }
    }
#undef TR_LOAD
}

__device__ __forceinline__ void i8_convert_fullk(const Frame& F, const float* src, int N, unsigned char* dst, const float* scale, int mode, int radd, float* cmax, int& rot) {
    LAS float* red = (LAS float*)F.lds;
    const int ntile = N / 64, tid = F.tid;
    int t = (F.blk + F.nblk - (rot % F.nblk)) % F.nblk;
    rot += ntile;
    const int lr = tid >> 4, c4 = (tid & 15) * 4, lane = F.lane, w = F.wave;
    for (; t < ntile; t += F.nblk) {
        f32x4 cur[32];
        const unsigned vo = (unsigned)(lr * 32 * N + t * 64 + c4) * 4u;
#pragma unroll
        for (int p = 0; p < 32; ++p) cur[p] = __builtin_nontemporal_load((const f32x4*)((const char*)(src + (size_t)p * N) + vo));
        f32x4 pm = zero4();
#pragma unroll
        for (int p4 = 0; p4 < 8; ++p4) {
            const f32x4 s4 = *(const f32x4*)(scale + lr * 32 + p4 * 4);
#pragma unroll
            for (int i = 0; i < 4; ++i) {
                const int p = p4 * 4 + i;
                cur[p] = cur[p] * s4[i];
                pm[0] = fmaxf(pm[0], fabsf(cur[p][0])); pm[1] = fmaxf(pm[1], fabsf(cur[p][1])); pm[2] = fmaxf(pm[2], fabsf(cur[p][2])); pm[3] = fmaxf(pm[3], fabsf(cur[p][3]));
            }
        }
#pragma unroll
        for (int i = 0; i < 4; ++i) { pm[i] = fmaxf(pm[i], shflx(pm[i], lane, 16)); pm[i] = fmaxf(pm[i], shflx(pm[i], lane, 32)); }
        __syncthreads();
        if (lane < 16) *(LAS f32x4*)(red + w * 64 + c4) = pm;
        __syncthreads();
        f32x4 cm = zero4();
#pragma unroll
        for (int ww = 0; ww < 8; ++ww) { const f32x4 v = *(LAS f32x4*)(red + ww * 64 + c4); cm[0] = fmaxf(cm[0], v[0]); cm[1] = fmaxf(cm[1], v[1]); cm[2] = fmaxf(cm[2], v[2]); cm[3] = fmaxf(cm[3], v[3]); }
#pragma unroll
        for (int i = 0; i < 4; ++i) {
            const float qs = cm[i] > 0.f ? 127.0f / cm[i] : 0.f;
            const int nn = t * 64 + c4 + i;
            const int r = PERM16 ? (mode ? slot_gu(nn, radd ? 1 : 0) : slot_win(nn)) : (mode ? (((nn >> 4) << 5) + (nn & 15) + radd) : nn);
            unsigned char* dp = dst + (size_t)r * 1024 + lr * 32;
#pragma unroll
            for (int h = 0; h < 2; ++h) {
                u32x4 o;
#pragma unroll
                for (int j = 0; j < 4; ++j) {
                    const int p = h * 16 + j * 4;
                    const int q0 = (int)rintf(cur[p][i] * qs), q1 = (int)rintf(cur[p + 1][i] * qs), q2 = (int)rintf(cur[p + 2][i] * qs), q3 = (int)rintf(cur[p + 3][i] * qs);
                    o[j] = (unsigned)(q0 & 255) | ((unsigned)(q1 & 255) << 8) | ((unsigned)(q2 & 255) << 16) | ((unsigned)(q3 & 255) << 24);
                }
                *(u32x4*)(dp + h * 16) = o;
            }
            if (lr == 0) cmax[r] = cm[i];
        }
    }
}

__device__ __forceinline__ void s5_tables(const Frame& F, int layer, int g) {
    LAS float* L = (LAS float*)F.lds;
    LAS float* apr = L;
    LAS float* api = L + 9 * 64;
    LAS float* bbr = L + 18 * 64;
    LAS float* bbi = bbr + 1024;
    LAS float* cr = bbi + 1024;
    LAS float* ci = cr + 1024;
    LAS float* kl = ci + 1024;
    const float* lam_re = F.in[5] + ((size_t)layer * NG + g) * NP;
    const float* lam_im = F.in[6] + ((size_t)layer * NG + g) * NP;
    const float log_dt = F.in[7][layer * NG + g];
    const float* b_re = F.in[8] + ((size_t)layer * NG + g) * NP * NH;
    const float* b_im = F.in[9] + ((size_t)layer * NG + g) * NP * NH;
    const float* c_re = F.in[10] + ((size_t)layer * NG + g) * NH * NP;
    const float* c_im = F.in[11] + ((size_t)layer * NG + g) * NH * NP;
    __syncthreads();
    if (F.tid < 64) {
        const int p = F.tid;
        const float lr = lam_re[p], li = lam_im[p], dt = expf(log_dt);
        const float mag = expf(lr * dt); float sn, cs; sincosf(li * dt, &sn, &cs);
        const float ar = mag * cs, ai = mag * sn;
        const float den = lr * lr + li * li, nr = ar - 1.0f;
        const float cfr = (nr * lr + ai * li) / den, cfi = (ai * lr - nr * li) / den;
        float pr = 1.0f, pi = 0.0f;
        for (int j = 0; j <= 8; ++j) { apr[j * 64 + p] = pr; api[j * 64 + p] = pi; const float t = pr * ar - pi * ai; pi = pr * ai + pi * ar; pr = t; }
        float qr = apr[8 * 64 + p], qi = api[8 * 64 + p];
        f32x2 w8; w8[0] = qr; w8[1] = qi;
        WSP(f32x2, WS_W8)[((size_t)layer * NG + g) * 64 + p] = w8;
        { const float m2 = expf(256.0f * lr * dt); float s2, c2; sincosf(256.0f * (li * dt), &s2, &c2); qr = m2 * c2; qi = m2 * s2; }
        f32x2 w256; w256[0] = qr; w256[1] = qi;
        WSP(f32x2, WS_W256)[((size_t)layer * NG + g) * 64 + p] = w256;
        for (int h = 0; h < 16; ++h) {
            const float br = b_re[p * 16 + h], bi = b_im[p * 16 + h];
            bbr[p * 16 + h] = cfr * br - cfi * bi;
            bbi[p * 16 + h] = cfr * bi + cfi * br;
        }
    }
    for (int i = F.tid; i < 1024; i += NTHREADS) { cr[i] = c_re[i]; ci[i] = c_im[i]; }
    __syncthreads();
    for (int i = F.tid; i < 2048; i += NTHREADS) {
        const int j = i >> 8, h = (i >> 4) & 15, h2 = i & 15;
        float acc = 0.f;
        for (int p = 0; p < 64; ++p) {
            const float wr = apr[j * 64 + p] * bbr[p * 16 + h2] - api[j * 64 + p] * bbi[p * 16 + h2];
            const float wi = apr[j * 64 + p] * bbi[p * 16 + h2] + api[j * 64 + p] * bbr[p * 16 + h2];
            acc += cr[h * 64 + p] * wr - ci[h * 64 + p] * wi;
        }
        kl[i] = acc;
    }
    __syncthreads();
    bf16_t* T = WSP(bf16_t, WS_S5T) + ((size_t)layer * NG + g) * 3 * 16384;
    for (int i = F.tid; i < 16384; i += NTHREADS) {
        const int row = i >> 7, col = i & 127;
        { const int p = row & 63, kt = col >> 4, h2 = col & 15, j = 7 - kt;
          const float wr = apr[j * 64 + p] * bbr[p * 16 + h2] - api[j * 64 + p] * bbi[p * 16 + h2];
          const float wi = apr[j * 64 + p] * bbi[p * 16 + h2] + api[j * 64 + p] * bbr[p * 16 + h2];
          T[i] = f2bf(row < 64 ? wr : wi); }
        { const int t = row >> 4, h = row & 15, kt = col >> 4, h2 = col & 15;
          T[16384 + i] = f2bf(kt <= t ? kl[((t - kt) << 8) + (h << 4) + h2] : 0.f); }
        { const int t = row >> 4, h = row & 15, p = col & 63, j = t + 1;
          const float wr = cr[h * 64 + p] * apr[j * 64 + p] - ci[h * 64 + p] * api[j * 64 + p];
          const float wi = cr[h * 64 + p] * api[j * 64 + p] + ci[h * 64 + p] * apr[j * 64 + p];
          T[32768 + i] = f2bf(col < 64 ? wr : -wi); }
    }
}

__device__ __forceinline__ void quant_row_store(const f32x4 (&v)[4], float ss, int lane, unsigned char* q8row, float* sa_row) {
    float mx = 0.f;
#pragma unroll
    for (int i = 0; i < 4; ++i) mx = fmaxf(fmaxf(mx, fmaxf(fabsf(v[i][0]), fabsf(v[i][1]))), fmaxf(fabsf(v[i][2]), fabsf(v[i][3])));
#pragma unroll
    for (int o = 32; o >= 1; o >>= 1) mx = fmaxf(mx, shflx(mx, lane, o));
    const float qs = mx > 0.f ? 127.0f / mx : 0.f;
#pragma unroll
    for (int i = 0; i < 4; ++i) {
        const int q0 = (int)rintf(v[i][0] * qs), q1 = (int)rintf(v[i][1] * qs), q2 = (int)rintf(v[i][2] * qs), q3 = (int)rintf(v[i][3] * qs);
        *(unsigned*)(q8row + i * 256 + lane * 4) = (unsigned)(q0 & 255) | ((unsigned)(q1 & 255) << 8) | ((unsigned)(q2 & 255) << 16) | ((unsigned)(q3 & 255) << 24);
    }
    if (lane == 0) *sa_row = mx * rsqrtf(ss * (1.0f / D) + EPS) * (1.0f / 127.0f);
}
__device__ __forceinline__ void prologue(const Frame& G) {
    const Frame F = local_frame(G);
    int rot = 0;
    for (int l = 0; l < DEPTH; ++l) {
        for (int r_ = 0; r_ <= REPS(15); ++r_) if (WMM == 3) i8_convert_fullk(F, F.in[3] + (size_t)l * D * DIN, DIN, WSP(unsigned char, WS_WIN + l * SZ_WIN), F.in[2] + l * D, 0, 0, WSP(float, WS_CMAX) + CMAX_WIN + l * DIN, rot);
        else for (int r_ = 0; r_ <= REPS(16); ++r_) tr_convert(F, F.in[3] + (size_t)l * D * DIN, D, DIN, WSP(bf16_t, WS_WIN + l * SZ_WIN), D, 0, F.in[2] + l * D, 0, 0, rot);
        for (int r_ = 0; r_ <= REPS(16); ++r_) tr_convert(F, F.in[13] + (size_t)l * 512 * 512, 512, 512, WSP(bf16_t, WS_WGLU + l * SZ_WGLU), 512, 0, nullptr, 0, 0, rot);
        for (int r_ = 0; r_ <= REPS(16); ++r_) tr_convert(F, F.in[15] + (size_t)l * 512 * D, 512, D, WSP(bf16_t, WS_WPROJ + l * SZ_WPROJ), D, 0, nullptr, 2, 0, rot);
        for (int r_ = 0; r_ <= REPS(16); ++r_) tr_convert(F, F.in[23] + (size_t)l * 512 * D, 512, D, WSP(bf16_t, WS_WPROJ + l * SZ_WPROJ), D, 512, nullptr, 2, 0, rot);
        for (int r_ = 0; r_ <= REPS(16); ++r_) tr_convert(F, F.in[24] + (size_t)l * D * D, D, D, WSP(bf16_t, WS_WOUT + l * SZ_WPROJ), D, 0, nullptr, 0, 0, rot, (l >= WOUT_F8_FROM) ? 1 : 0);
    }
    constexpr int GUM = (UMM == 3) ? 2 : (UMM == 1 ? 1 : 0);
    float* cmx = WSP(float, WS_CMAX);
    for (int j = 0; j < 2; ++j) {
        const float* fn = F.in[25] + (size_t)(2 * j) * D;
        if (UMM == 3) {
            for (int r_ = 0; r_ <= REPS(15); ++r_) i8_convert_fullk(F, F.in[26] + (size_t)j * D * DFF, DFF, WSP(unsigned char, WS_DGU + j * SZ_DGU), fn, 1, 0, cmx + j * 2 * DFF, rot);
            for (int r_ = 0; r_ <= REPS(15); ++r_) i8_convert_fullk(F, F.in[27] + (size_t)j * D * DFF, DFF, WSP(unsigned char, WS_DGU + j * SZ_DGU), fn, 1, 16, cmx + j * 2 * DFF, rot);
        } else {
        tr_convert(F, F.in[26] + (size_t)j * D * DFF, D, DFF, WSP(bf16_t, WS_DGU + j * SZ_DGU), D, 0, fn, 1, 0, rot, GUM, cmx + j * 2 * DFF);
        tr_convert(F, F.in[27] + (size_t)j * D * DFF, D, DFF, WSP(bf16_t, WS_DGU + j * SZ_DGU), D, 0, fn, 1, 16, rot, GUM, cmx + j * 2 * DFF);
        }
        for (int r_ = 0; r_ <= REPS(16); ++r_) tr_convert(F, F.in[28] + (size_t)j * DFF * D, DFF, D, WSP(bf16_t, WS_DDN + j * SZ_DDN), DFF, 0, nullptr, 0, 0, rot, (j == 0 ? DESZ_D : DESZ_D2) == 1);
        const float* fm = F.in[25] + (size_t)(2 * j + 1) * D;
        for (int e = 0; e < NEXP; ++e) {
            if (UMM == 3) {
                for (int r_ = 0; r_ <= REPS(15); ++r_) i8_convert_fullk(F, F.in[31] + ((size_t)j * NEXP + e) * D * EFF, EFF, WSP(unsigned char, WS_MGU + (j * NEXP + e) * SZ_MGU), fm, 1, 0, cmx + CMAX_MOE + (j * NEXP + e) * 2 * EFF, rot);
                for (int r_ = 0; r_ <= REPS(15); ++r_) i8_convert_fullk(F, F.in[32] + ((size_t)j * NEXP + e) * D * EFF, EFF, WSP(unsigned char, WS_MGU + (j * NEXP + e) * SZ_MGU), fm, 1, 16, cmx + CMAX_MOE + (j * NEXP + e) * 2 * EFF, rot);
            } else {
            tr_convert(F, F.in[31] + ((size_t)j * NEXP + e) * D * EFF, D, EFF, WSP(bf16_t, WS_MGU + (j * NEXP + e) * SZ_MGU), D, 0, fm, 1, 0, rot, GUM, cmx + CMAX_MOE + (j * NEXP + e) * 2 * EFF);
            tr_convert(F, F.in[32] + ((size_t)j * NEXP + e) * D * EFF, D, EFF, WSP(bf16_t, WS_MGU + (j * NEXP + e) * SZ_MGU), D, 0, fm, 1, 16, rot, GUM, cmx + CMAX_MOE + (j * NEXP + e) * 2 * EFF);
            }
            for (int r_ = 0; r_ <= REPS(16); ++r_) tr_convert(F, F.in[33] + ((size_t)j * NEXP + e) * EFF * D, EFF, D, WSP(bf16_t, WS_MDN + (j * NEXP + e) * SZ_MDN), EFF, 0, nullptr, 0, 0, rot, DESZ_M == 1);
        }
    }
    for (int r_ = 0; r_ <= REPS(17); ++r_) for (int u = F.blk; u < DEPTH * NG; u += F.nblk) s5_tables(F, u / NG, u % NG);
    {
        bf16_t* lw = WSP(bf16_t, WS_LRUW);
        for (int i = F.blk * NTHREADS + F.tid; i < DEPTH * 8 * 2 * 4096; i += F.nblk * NTHREADS) {
            const int h = i & 63, k = (i >> 6) & 63, gt = (i >> 12) & 1, lh = i >> 13;
            lw[i] = f2bf(F.in[gt ? 20 : 18][(size_t)lh * 4096 + h * 64 + k]);
        }
    }
    float* hs = WSP(float, WS_HS); bf16_t* hsb = WSP(bf16_t, WS_HSB); float* rsp = WSP(float, WS_RSP);
    for (int r_ = 0; r_ <= REPS(18); ++r_) for (int row = F.blk * 8 + F.wave; row < MP; row += F.nblk * 8) {
        const float* src = row < NTOK ? F.in[0] + (size_t)row * D : (row < NV ? F.in[1] + (size_t)(row - NTOK) * D : nullptr);
        float ss = 0.f; f32x4 vv[4];
#pragma unroll
        for (int i = 0; i < 4; ++i) {
            const int k = i * 256 + F.lane * 4;
            f32x4 v = src ? __builtin_nontemporal_load((const f32x4*)(src + k)) : zero4();
            vv[i] = v;
            if (!SKIP_HS0 || row >= NV) *(f32x4*)(hs + (size_t)row * D + k) = v;
            if (NEED_HSB) { u32x2 o; o[0] = pk2(v[0], v[1]); o[1] = pk2(v[2], v[3]); *(u32x2*)(hsb + (size_t)row * D + k) = o; }
            ss += v[0] * v[0] + v[1] * v[1] + v[2] * v[2] + v[3] * v[3];
        }
#pragma unroll
        for (int o = 32; o >= 1; o >>= 1) ss += shflx(ss, F.lane, o);
        if (NEED_HSB && F.lane < 16) rsp[(size_t)row * 16 + F.lane] = (F.lane == 0) ? ss : 0.f;
        if (WMM == 3 && row < NV) quant_row_store(vv, ss, F.lane, WSP(unsigned char, WS_HSB8) + (size_t)row * D, WSP(float, WS_SA) + row);
    }
}

__device__ __forceinline__ void prologue2(const Frame& G) {
    const Frame F = local_frame(G);
    int rot = 0;
    float* cmx = WSP(float, WS_CMAX);
    if (WMM == 3) for (int l = 0; l < DEPTH; ++l) tr_convert(F, F.in[3] + (size_t)l * D * DIN, D, DIN, WSP(bf16_t, WS_WIN + l * SZ_WIN), D, 0, F.in[2] + l * D, 0, 0, rot, 3, cmx + CMAX_WIN + l * DIN);
    if (UMM == 3) for (int j = 0; j < 2; ++j) {
        const float* fn = F.in[25] + (size_t)(2 * j) * D;
        tr_convert(F, F.in[26] + (size_t)j * D * DFF, D, DFF, WSP(bf16_t, WS_DGU + j * SZ_DGU), D, 0, fn, 1, 0, rot, 3, cmx + j * 2 * DFF);
        tr_convert(F, F.in[27] + (size_t)j * D * DFF, D, DFF, WSP(bf16_t, WS_DGU + j * SZ_DGU), D, 0, fn, 1, 16, rot, 3, cmx + j * 2 * DFF);
        const float* fm = F.in[25] + (size_t)(2 * j + 1) * D;
        for (int e = 0; e < NEXP; ++e) {
            tr_convert(F, F.in[31] + ((size_t)j * NEXP + e) * D * EFF, D, EFF, WSP(bf16_t, WS_MGU + (j * NEXP + e) * SZ_MGU), D, 0, fm, 1, 0, rot, 3, cmx + CMAX_MOE + (j * NEXP + e) * 2 * EFF);
            tr_convert(F, F.in[32] + ((size_t)j * NEXP + e) * D * EFF, D, EFF, WSP(bf16_t, WS_MGU + (j * NEXP + e) * SZ_MGU), D, 0, fm, 1, 16, rot, 3, cmx + CMAX_MOE + (j * NEXP + e) * 2 * EFF);
        }
    }
}
__device__ __forceinline__ void qnorm_rows(const Frame& G, int r_lo = -1, int r_hi = NV) {
    const Frame F = local_frame(G);
    const float* hs = WSP(float, WS_HS); unsigned char* q8 = WSP(unsigned char, WS_HSB8); float* sa = WSP(float, WS_SA);
    const int l16 = F.lane & 15;
    const int step = (r_lo < 0 ? F.nblk * 32 : 32);
    for (int r0 = (r_lo < 0 ? (F.blk * 8 + F.wave) * 4 : r_lo + F.wave * 4); r0 < r_hi; r0 += 3 * step) {
        const int rowA = r0 + (F.lane >> 4), rowB = rowA + step, rowC = rowB + step; const bool va = rowA < r_hi, vb = rowB < r_hi, vc = rowC < r_hi;
        f32x4 ha[16], hb[16], hc[16];
#pragma unroll
        for (int i = 0; i < 16; ++i) ha[i] = va ? __builtin_nontemporal_load((const f32x4*)(hs + (size_t)rowA * D + i * 64 + l16 * 4)) : zero4();
#pragma unroll
        for (int i = 0; i < 16; ++i) hb[i] = vb ? __builtin_nontemporal_load((const f32x4*)(hs + (size_t)rowB * D + i * 64 + l16 * 4)) : zero4();
#pragma unroll
        for (int i = 0; i < 16; ++i) hc[i] = vc ? __builtin_nontemporal_load((const f32x4*)(hs + (size_t)rowC * D + i * 64 + l16 * 4)) : zero4();
#pragma unroll
        for (int rr = 0; rr < 3; ++rr) {
            const int row = rr == 0 ? rowA : (rr == 1 ? rowB : rowC); const bool rv = rr == 0 ? va : (rr == 1 ? vb : vc);
            if (rr == 2 && !__any(vc)) break;
            float ss = 0.f, mx = 0.f;
#pragma unroll
            for (int i = 0; i < 16; ++i) { const f32x4 v = rr == 0 ? ha[i] : (rr == 1 ? hb[i] : hc[i]); ss += v[0] * v[0] + v[1] * v[1] + v[2] * v[2] + v[3] * v[3]; mx = fmaxf(fmaxf(mx, fmaxf(fabsf(v[0]), fabsf(v[1]))), fmaxf(fabsf(v[2]), fabsf(v[3]))); }
#pragma unroll
            for (int o = 8; o >= 1; o >>= 1) { ss += shflx(ss, F.lane, o); mx = fmaxf(mx, shflx(mx, F.lane, o)); }
            if (rv) {
                const float ri = rsqrtf(ss * (1.0f / D) + EPS), qs = mx > 0.f ? 127.0f / mx : 0.f;
#pragma unroll
                for (int i = 0; i < 16; ++i) {
                    const f32x4 v = rr == 0 ? ha[i] : (rr == 1 ? hb[i] : hc[i]);
                    const int q0 = (int)rintf(v[0] * qs), q1 = (int)rintf(v[1] * qs), q2 = (int)rintf(v[2] * qs), q3 = (int)rintf(v[3] * qs);
                    *(unsigned*)(q8 + (size_t)row * D + i * 64 + l16 * 4) = (unsigned)(q0 & 255) | ((unsigned)(q1 & 255) << 8) | ((unsigned)(q2 & 255) << 16) | ((unsigned)(q3 & 255) << 24);
                }
                if (l16 == 0) sa[row] = mx * ri * (1.0f / 127.0f);
            }
        }
    }
}

struct Side { f32x4 a, b; };
struct Col { f32x4 c0, c1; };
struct APlain { const bf16_t* A; int lda; __device__ __forceinline__ const bf16_t* row(int r) const { return A + (size_t)r * lda; } };
struct AGather { const bf16_t* A; int lda; const int* idx; __device__ __forceinline__ const bf16_t* row(int r) const { return A + (size_t)idx[r] * lda; } };
struct BPlain { const bf16_t* Bt; __device__ __forceinline__ const bf16_t* base(int) const { return Bt; } };
struct BExpert { const bf16_t* Bt; size_t estride; const int* texp; __device__ __forceinline__ const bf16_t* base(int m0) const { return Bt + (size_t)texp[m0 >> 8] * estride; } };

template <class AP, class BP, class Epi>
__device__ __forceinline__ void wgemm_tile(const AP& ap, const BP& bp, int K, int m0, int n0, const Epi& E, int lane) {
    const int fr = lane & 15, fq = lane >> 4;
    const bf16_t* a_ptr[2]; const bf16_t* b_ptr[4];
#pragma unroll
    for (int mi = 0; mi < 2; ++mi) a_ptr[mi] = ap.row(m0 + 16 * mi + fr) + 8 * fq;
    const bf16_t* Bt = bp.base(m0);
#pragma unroll
    for (int ni = 0; ni < 4; ++ni) b_ptr[ni] = Bt + (size_t)(n0 + 16 * ni + fr) * K + 8 * fq;
    f32x4 acc[2][4];
#pragma unroll
    for (int mi = 0; mi < 2; ++mi)
#pragma unroll
        for (int ni = 0; ni < 4; ++ni) acc[mi][ni] = zero4();
    const int kh = Epi::MIDK ? K / 2 : K;
#pragma unroll 1
    for (int seg = 0; seg < (Epi::MIDK ? 2 : 1); ++seg) {
        const int k0 = seg * kh, k1 = k0 + kh;
#pragma unroll 4
        for (int k = k0; k < k1; k += 32) {
            bf16x8 af[2], bf[4];
#pragma unroll
            for (int mi = 0; mi < 2; ++mi) af[mi] = *(const bf16x8*)(a_ptr[mi] + k);
#pragma unroll
            for (int ni = 0; ni < 4; ++ni) bf[ni] = *(const bf16x8*)(b_ptr[ni] + k);
#pragma unroll
            for (int mi = 0; mi < 2; ++mi)
#pragma unroll
                for (int ni = 0; ni < 4; ++ni) acc[mi][ni] = __builtin_amdgcn_mfma_f32_16x16x32_bf16(bf[ni], af[mi], acc[mi][ni], 0, 0, 0);
        }
        if constexpr (Epi::MIDK) {
            if (seg == 0) {
#pragma unroll
                for (int mi = 0; mi < 2; ++mi)
#pragma unroll
                    for (int q = 0; q < 2; ++q) E.mid(m0 + 16 * mi + fr, n0 + 32 * q, fq, acc[mi][2 * q], acc[mi][2 * q + 1]);
            }
        }
    }
    Col cl[2]; float rsv[2]; Side sd[2][2];
#pragma unroll
    for (int q = 0; q < 2; ++q) cl[q] = E.col(n0 + 32 * q, fq);
#pragma unroll
    for (int mi = 0; mi < 2; ++mi) {
        rsv[mi] = E.row_scale(m0 + 16 * mi + fr, 0);
#pragma unroll
        for (int q = 0; q < 2; ++q) sd[mi][q] = E.side(m0 + 16 * mi + fr, n0 + 32 * q, fq, 0);
    }
#pragma unroll
    for (int mi = 0; mi < 2; ++mi) {
        const int row = m0 + 16 * mi + fr;
        const float rs = rsv[mi];
        float ss = 0.f;
#pragma unroll
        for (int q = 0; q < 2; ++q) ss += E.store(row, rs, n0 + 32 * q, fq, acc[mi][2 * q], acc[mi][2 * q + 1], sd[mi][q], cl[q]);
        if constexpr (Epi::ROWSS) {
            ss += shflx(ss, lane, 16); ss += shflx(ss, lane, 32);
            if (fq == 0) E.write_ss(row, n0 >> 6, ss);
        }
    }
}
template <class AP, class BP, class Epi>
__device__ __forceinline__ void wgemm_all(const Frame& G, const AP& ap, const BP& bp, int m_lo, int m_hi, int N, int K, const Epi& E) {
    const Frame F = local_frame(G);
    const int tn = N / 64, tm = (m_hi - m_lo) / 32, nt = tm * tn;
    for (int t = F.blk * 8 + F.wave; t < nt; t += F.nblk * 8) wgemm_tile(ap, bp, K, m_lo + (t / tn) * 32, (t % tn) * 64, E, F.lane);
}

__device__ __forceinline__ float rinv_from_partials(const float* rsp, int row) {
    const f32x4* p = (const f32x4*)(rsp + (size_t)row * 16);
    const f32x4 a = p[0], b = p[1], c = p[2], d = p[3];
    const float s = ((a[0] + a[1]) + (a[2] + a[3])) + ((b[0] + b[1]) + (b[2] + b[3])) + ((c[0] + c[1]) + (c[2] + c[3])) + ((d[0] + d[1]) + (d[2] + d[3]));
    return rsqrtf(s * (1.0f / D) + EPS);
}
__device__ __forceinline__ void st4bf(bf16_t* p, f32x4 v) { u32x2 o; o[0] = pk2(v[0], v[1]); o[1] = pk2(v[2], v[3]); *(u32x2*)p = o; }
__device__ __forceinline__ f32x4 ld4bf(const bf16_t* p) { const u32x2 o = *(const u32x2*)p; f32x4 v; v[0] = __uint_as_float(o[0] << 16); v[1] = __uint_as_float(o[0] & 0xffff0000u); v[2] = __uint_as_float(o[1] << 16); v[3] = __uint_as_float(o[1] & 0xffff0000u); return v; }

__device__ __forceinline__ f32x4 bits4(u32x2 lo, u32x2 hi) { f32x4 r; r[0] = __uint_as_float(lo[0]); r[1] = __uint_as_float(lo[1]); r[2] = __uint_as_float(hi[0]); r[3] = __uint_as_float(hi[1]); return r; }
__device__ __forceinline__ f32x4 unpk4(float w0, float w1) { const unsigned a = __float_as_uint(w0), b = __float_as_uint(w1); f32x4 v; v[0] = __uint_as_float(a << 16); v[1] = __uint_as_float(a & 0xffff0000u); v[2] = __uint_as_float(b << 16); v[3] = __uint_as_float(b & 0xffff0000u); return v; }

struct Col16 { f32x4 b[4]; };
__device__ __forceinline__ void st8bf(bf16_t* p, f32x4 a, f32x4 b) { u32x4 o; o[0] = pk2(a[0], a[1]); o[1] = pk2(a[2], a[3]); o[2] = pk2(b[0], b[1]); o[3] = pk2(b[2], b[3]); *(u32x4*)p = o; }
constexpr bool GATES8 = PERM16;
__device__ __forceinline__ unsigned pk4u8(f32x4 g) {
    unsigned o = 0u;
    o = __builtin_amdgcn_cvt_pk_u8_f32(rintf(fmaxf(g[0] * 255.0f, 1.0f)), 0, o); o = __builtin_amdgcn_cvt_pk_u8_f32(rintf(fmaxf(g[1] * 255.0f, 1.0f)), 1, o);
    o = __builtin_amdgcn_cvt_pk_u8_f32(rintf(fmaxf(g[2] * 255.0f, 1.0f)), 2, o); o = __builtin_amdgcn_cvt_pk_u8_f32(rintf(fmaxf(g[3] * 255.0f, 1.0f)), 3, o);
    return o;
}
__device__ __forceinline__ f32x4 un4u8(unsigned w) { f32x4 o; o[0] = (float)(w & 255u); o[1] = (float)((w >> 8) & 255u); o[2] = (float)((w >> 16) & 255u); o[3] = (float)(w >> 24); return o; }
__device__ __forceinline__ void ld16u8(const unsigned char* p, f32x4 (&o)[4]) { const u32x4 a = *(const u32x4*)p; o[0] = un4u8(a[0]); o[1] = un4u8(a[1]); o[2] = un4u8(a[2]); o[3] = un4u8(a[3]); }
struct EpiWin {
    static constexpr bool DRAIN_STORES = true;
    static constexpr bool MIDK = false, ROWSS = false, P16 = PERM16; static constexpr int EB = 2;
    __device__ __forceinline__ Col16 col16(int pn, int wc, int fq) const { Col16 c; const int col0 = pn * 256 + wc * 64 + fq * 16;
        if (col0 >= 1536) { c.b[0] = *(const f32x4*)(mbias + col0 - 1536); c.b[1] = *(const f32x4*)(mbias + col0 - 1536 + 4); c.b[2] = *(const f32x4*)(mbias + col0 - 1536 + 8); c.b[3] = *(const f32x4*)(mbias + col0 - 1536 + 12); }
        else { c.b[0] = (f32x4){0.f, 0.f, 0.f, 0.f}; c.b[1] = c.b[0]; c.b[2] = c.b[0]; c.b[3] = c.b[0]; } return c; }
    __device__ __forceinline__ f32x4 act4(int seg, f32x4 v, f32x4 b) const {
        if (seg < 2) return v;
        f32x4 o;
        if (seg == 2) { o[0] = gelu_tanh(v[0]); o[1] = gelu_tanh(v[1]); o[2] = gelu_tanh(v[2]); o[3] = gelu_tanh(v[3]); }
        else { o[0] = sigmoidf_(v[0] + b[0]); o[1] = sigmoidf_(v[1] + b[1]); o[2] = sigmoidf_(v[2] + b[2]); o[3] = sigmoidf_(v[3] + b[3]); }
        return o; }
    __device__ __forceinline__ bf16_t* outp(int seg, int row, int col0) const { return seg == 0 ? us5 + ((size_t)(col0 >> 4) * MP + row) * 16 + (col0 & 15) : seg == 1 ? xlru + (size_t)row * 512 + (col0 - 512) : seg == 2 ? gg + (size_t)row * 512 + (col0 - 1024) : gates + (size_t)row * 2048 + (col0 - 1536); }
    __device__ __forceinline__ void store16(int row, float rs, int pn, int wc, int fq, f32x4 v00, f32x4 v01, f32x4 v10, f32x4 v11, const Col16& c) const {
        const int col0 = pn * 256 + wc * 64 + fq * 16, seg = col0 < 1536 ? (col0 >> 9) : 3;
        if (GATES8 && seg == 3) {
            u32x4 o; o[0] = pk4u8(act4(3, v00 * rs, c.b[0])); o[1] = pk4u8(act4(3, v01 * rs, c.b[1])); o[2] = pk4u8(act4(3, v10 * rs, c.b[2])); o[3] = pk4u8(act4(3, v11 * rs, c.b[3]));
            *(u32x4*)((unsigned char*)gates + (size_t)row * 2048 + (col0 - 1536)) = o;
            return;
        }
        bf16_t* p = outp(seg, row, col0);
        st8bf(p, act4(seg, v00 * rs, c.b[0]), act4(seg, v01 * rs, c.b[1])); st8bf(p + 8, act4(seg, v10 * rs, c.b[2]), act4(seg, v11 * rs, c.b[3]));
    }
    __device__ __forceinline__ void rider_pair(int row, float rs, int pn, int bj, int wc, int fq, f32x4 v0, f32x4 v1) const {
        const int col0 = pn * 256 + wc * 64 + fq * 16, seg = col0 < 1536 ? (col0 >> 9) : 3;
        f32x4 b0 = (f32x4){0.f, 0.f, 0.f, 0.f}, b1 = b0;
        if (seg == 3) { b0 = *(const f32x4*)(mbias + col0 - 1536 + bj * 8); b1 = *(const f32x4*)(mbias + col0 - 1536 + bj * 8 + 4); }
        if (GATES8 && seg == 3) { u32x2 o; o[0] = pk4u8(act4(3, v0 * rs, b0)); o[1] = pk4u8(act4(3, v1 * rs, b1)); *(u32x2*)((unsigned char*)gates + (size_t)row * 2048 + (col0 - 1536) + bj * 8) = o; return; }
        st8bf(outp(seg, row, col0) + bj * 8, act4(seg, v0 * rs, b0), act4(seg, v1 * rs, b1));
    }
    const float* rsp; bf16_t* us5; bf16_t* xlru; bf16_t* gg; bf16_t* gates; const float* mbias;
    __device__ __forceinline__ float row_scale(int row, int) const { return WMM == 3 ? 1.0f : rinv_from_partials(rsp, row); }
    __device__ __forceinline__ Col col(int cb, int fq) const { Col c; if (cb >= 1536) { c.c0 = *(const f32x4*)(mbias + (cb - 1536) + 4 * fq); c.c1 = *(const f32x4*)(mbias + (cb - 1536) + 16 + 4 * fq); } else { c.c0 = (f32x4){0.f, 0.f, 0.f, 0.f}; c.c1 = c.c0; } return c; }
    __device__ __forceinline__ Side side(int, int, int, int) const { Side s; s.a = (f32x4){0.f, 0.f, 0.f, 0.f}; s.b = s.a; return s; }
    __device__ __forceinline__ void one(int row, float rs, int c, f32x4 v, f32x4 b) const {
        v = v * rs;
        if (c < 512) st4bf(us5 + ((size_t)(c >> 4) * MP + row) * 16 + (c & 15), v);
        else if (c < 1024) st4bf(xlru + (size_t)row * 512 + (c - 512), v);
        else if (c < 1536) { f32x4 o; o[0] = gelu_tanh(v[0]); o[1] = gelu_tanh(v[1]); o[2] = gelu_tanh(v[2]); o[3] = gelu_tanh(v[3]); st4bf(gg + (size_t)row * 512 + (c - 1024), o); }
        else { f32x4 o; o[0] = sigmoidf_(v[0] + b[0]); o[1] = sigmoidf_(v[1] + b[1]); o[2] = sigmoidf_(v[2] + b[2]); o[3] = sigmoidf_(v[3] + b[3]); st4bf(gates + (size_t)row * 2048 + (c - 1536), o); }
    }
    __device__ __forceinline__ float store(int row, float rs, int cb, int fq, f32x4 v0, f32x4 v1, const Side&, const Col& cl) const { one(row, rs, cb + 4 * fq, v0, cl.c0); one(row, rs, cb + 16 + 4 * fq, v1, cl.c1); return 0.f; }
};
struct EpiGlu {
    static constexpr bool MIDK = false, ROWSS = false, P16 = false; static constexpr int EB = 2;
    const bf16_t* ys5; const float* bglu; bf16_t* solo;
    __device__ __forceinline__ float row_scale(int, int) const { return 1.f; }
    __device__ __forceinline__ Col col(int cb, int fq) const { Col c; c.c0 = *(const f32x4*)(bglu + cb + 4 * fq); c.c1 = *(const f32x4*)(bglu + cb + 16 + 4 * fq); return c; }
    __device__ __forceinline__ Side side(int row, int cb, int fq, int) const { Side s; s.a = bits4(*(const u32x2*)(ys5 + (size_t)row * 512 + cb + 4 * fq), *(const u32x2*)(ys5 + (size_t)row * 512 + cb + 16 + 4 * fq)); s.b = (f32x4){0.f, 0.f, 0.f, 0.f}; return s; }
    __device__ __forceinline__ void one(int row, int c, f32x4 v, f32x4 y, f32x4 b) const {
        f32x4 o; o[0] = y[0] * sigmoidf_(v[0] + b[0]); o[1] = y[1] * sigmoidf_(v[1] + b[1]); o[2] = y[2] * sigmoidf_(v[2] + b[2]); o[3] = y[3] * sigmoidf_(v[3] + b[3]);
        st4bf(solo + (size_t)row * D + c, o);
    }
    __device__ __forceinline__ float store(int row, float, int cb, int fq, f32x4 v0, f32x4 v1, const Side& s, const Col& cl) const { one(row, cb + 4 * fq, v0, unpk4(s.a[0], s.a[1]), cl.c0); one(row, cb + 16 + 4 * fq, v1, unpk4(s.a[2], s.a[3]), cl.c1); return 0.f; }
};
struct EpiProj {
    static constexpr bool MIDK = true, ROWSS = false, P16 = false; static constexpr int EB = 2;
    const bf16_t* gates; bf16_t* y;
    __device__ __forceinline__ float row_scale(int, int) const { return 1.f; }
    __device__ __forceinline__ Col col(int, int) const { Col c; c.c0 = (f32x4){0.f, 0.f, 0.f, 0.f}; c.c1 = c.c0; return c; }
    __device__ __forceinline__ Side side(int row, int cb, int fq, int) const { Side s; s.a = bits4(*(const u32x2*)(gates + (size_t)row * 2048 + 1024 + cb + 4 * fq), *(const u32x2*)(gates + (size_t)row * 2048 + 1024 + cb + 16 + 4 * fq)); s.b = s.a; return s; }
    __device__ __forceinline__ void mid1(int row, int c, f32x4& v) const {
        const f32x4 g0 = ld4bf(gates + (size_t)row * 2048 + c), g1 = ld4bf(gates + (size_t)row * 2048 + 1024 + c);
        v[0] *= g0[0] / g1[0]; v[1] *= g0[1] / g1[1]; v[2] *= g0[2] / g1[2]; v[3] *= g0[3] / g1[3];
    }
    __device__ __forceinline__ void mid(int row, int cb, int fq, f32x4& v0, f32x4& v1) const { mid1(row, cb + 4 * fq, v0); mid1(row, cb + 16 + 4 * fq, v1); }
    __device__ __forceinline__ float store(int row, float, int cb, int fq, f32x4 v0, f32x4 v1, const Side& s, const Col&) const {
        st4bf(y + (size_t)row * D + cb + 4 * fq, v0 * unpk4(s.a[0], s.a[1])); st4bf(y + (size_t)row * D + cb + 16 + 4 * fq, v1 * unpk4(s.a[2], s.a[3])); return 0.f; }
};
__device__ __forceinline__ void st16_sc1(float* p, f32x4 v) { asm volatile("global_store_dwordx4 %0, %1, off sc1\n\ts_nop 1" :: "v"(p), "v"(v) : "memory"); }
struct EpiRes {
    static constexpr bool MIDK = false, ROWSS = NEED_HSB, P16 = false; static constexpr int EB = 2;
    float* hs; bf16_t* hsb; float* rsp; int dry; unsigned char* hsb8; float sc; const float* res;
    __device__ __forceinline__ float row_scale(int, int) const { return 1.f; }
    __device__ __forceinline__ Col col(int, int) const { Col c; c.c0 = (f32x4){0.f, 0.f, 0.f, 0.f}; c.c1 = c.c0; return c; }
    __device__ __forceinline__ Side side(int row, int cb, int fq, int) const { Side s; s.a = __builtin_nontemporal_load((const f32x4*)(res + (size_t)row * D + cb + 4 * fq)); s.b = __builtin_nontemporal_load((const f32x4*)(res + (size_t)row * D + cb + 16 + 4 * fq)); return s; }
    __device__ __forceinline__ float one(int row, int c, f32x4 v, f32x4 old) const {
        float s_ = sc; asm volatile("" : "+v"(s_));
        const f32x4 h = old + v * s_; if (!dry) { if (FUSE_POST) st16_sc1(hs + (size_t)row * D + c, h); else *(f32x4*)(hs + (size_t)row * D + c) = h; if (NEED_HSB) st4bf(hsb + (size_t)row * D + c, h); if (hsb8) *(unsigned*)(hsb8 + (size_t)row * D + c) = pk4f8(h[0], h[1], h[2], h[3]); }
        return h[0] * h[0] + h[1] * h[1] + h[2] * h[2] + h[3] * h[3];
    }
    __device__ __forceinline__ float store(int row, float, int cb, int fq, f32x4 v0, f32x4 v1, const Side& s, const Col&) const { return one(row, cb + 4 * fq, v0, s.a) + one(row, cb + 16 + 4 * fq, v1, s.b); }
    __device__ __forceinline__ void write_ss(int row, int pidx, float ss) const { if (!dry) rsp[(size_t)row * 16 + pidx] = ss; }
};
struct EpiUp {
    static constexpr bool MIDK = false, ROWSS = false, P16 = PERM16; static constexpr int EB = 2;
    const float* rsp; unsigned char* act; int dry; int f8;
    __device__ __forceinline__ Col16 col16(int, int, int) const { Col16 c; c.b[0] = (f32x4){0.f, 0.f, 0.f, 0.f}; c.b[1] = c.b[0]; c.b[2] = c.b[0]; c.b[3] = c.b[0]; return c; }
    __device__ __forceinline__ f32x4 sw4(float rs, f32x4 g, f32x4 u) const {
        const f32x4 x = g * rs, y = u * rs;
        f32x4 e; e[0] = __expf(-x[0]); e[1] = __expf(-x[1]); e[2] = __expf(-x[2]); e[3] = __expf(-x[3]);
        const f32x4 d = e + 1.0f;
        f32x4 r; r[0] = __builtin_amdgcn_rcpf(d[0]); r[1] = __builtin_amdgcn_rcpf(d[1]); r[2] = __builtin_amdgcn_rcpf(d[2]); r[3] = __builtin_amdgcn_rcpf(d[3]);
        return (x * r) * y; }
    __device__ __forceinline__ void store16(int row, float rs, int pn, int wc, int fq, f32x4 v00, f32x4 v01, f32x4 v10, f32x4 v11, const Col16&) const {
        if (dry) { asm volatile("" :: "v"(v00), "v"(v01), "v"(v10), "v"(v11)); return; }
        const f32x4 o0 = sw4(rs, v00, v01), o1 = sw4(rs, v10, v11);
        const size_t a0 = (size_t)row * DFF + pn * 128 + wc * 32 + fq * 8;
        if (f8) { u32x2 o; o[0] = pk4f8(o0[0], o0[1], o0[2], o0[3]); o[1] = pk4f8(o1[0], o1[1], o1[2], o1[3]); *(u32x2*)(act + a0) = o; } else st8bf((bf16_t*)act + a0, o0, o1);
    }
    __device__ __forceinline__ void rider_pair(int row, float rs, int pn, int bj, int wc, int fq, f32x4 v0, f32x4 v1) const {
        const f32x4 o = sw4(rs, v0, v1);
        const size_t a0 = (size_t)row * DFF + pn * 128 + wc * 32 + fq * 8 + bj * 4;
        if (f8) *(unsigned*)(act + a0) = pk4f8(o[0], o[1], o[2], o[3]); else st4bf((bf16_t*)act + a0, o);
    }
    __device__ __forceinline__ float row_scale(int row, int) const { return (dry || UMM == 3) ? 1.f : rinv_from_partials(rsp, row) * (UMM == 1 ? FSC : 1.0f); }
    __device__ __forceinline__ Col col(int, int) const { Col c; c.c0 = (f32x4){0.f, 0.f, 0.f, 0.f}; c.c1 = c.c0; return c; }
    __device__ __forceinline__ Side side(int, int, int, int) const { Side s; s.a = (f32x4){0.f, 0.f, 0.f, 0.f}; s.b = s.a; return s; }
    __device__ __forceinline__ float store(int row, float rs, int cb, int fq, f32x4 v0, f32x4 v1, const Side&, const Col&) const {
        if (dry) { asm volatile("" :: "v"(v0), "v"(v1)); return 0.f; }
        f32x4 o; o[0] = silu_(rs * v0[0]) * (rs * v1[0]); o[1] = silu_(rs * v0[1]) * (rs * v1[1]); o[2] = silu_(rs * v0[2]) * (rs * v1[2]); o[3] = silu_(rs * v0[3]) * (rs * v1[3]);
        if (f8) *(unsigned*)(act + (size_t)row * DFF + (cb >> 1) + 4 * fq) = pk4f8(o[0], o[1], o[2], o[3]); else st4bf((bf16_t*)act + (size_t)row * DFF + (cb >> 1) + 4 * fq, o);
        return 0.f;
    }
};
struct EpiMoeUp {
    static constexpr bool MIDK = false, ROWSS = false, P16 = PERM16; static constexpr int EB = 2;
    unsigned char* act;
    __device__ __forceinline__ Col16 col16(int, int, int) const { Col16 c; c.b[0] = (f32x4){0.f, 0.f, 0.f, 0.f}; c.b[1] = c.b[0]; c.b[2] = c.b[0]; c.b[3] = c.b[0]; return c; }
    __device__ __forceinline__ f32x4 sw4(float rs, f32x4 g, f32x4 u) const {
        const f32x4 x = g * rs, y = u * rs;
        f32x4 e; e[0] = __expf(-x[0]); e[1] = __expf(-x[1]); e[2] = __expf(-x[2]); e[3] = __expf(-x[3]);
        const f32x4 d = e + 1.0f;
        f32x4 r; r[0] = __builtin_amdgcn_rcpf(d[0]); r[1] = __builtin_amdgcn_rcpf(d[1]); r[2] = __builtin_amdgcn_rcpf(d[2]); r[3] = __builtin_amdgcn_rcpf(d[3]);
        return (x * r) * y; }
    __device__ __forceinline__ void store16(int row, float rs, int pn, int wc, int fq, f32x4 v00, f32x4 v01, f32x4 v10, f32x4 v11, const Col16&) const {
        const f32x4 o0 = sw4(rs, v00, v01), o1 = sw4(rs, v10, v11);
        const size_t a0 = (size_t)row * EFF + pn * 128 + wc * 32 + fq * 8;
        if constexpr (DESZ_M == 1) { u32x2 o; o[0] = pk4f8(o0[0], o0[1], o0[2], o0[3]); o[1] = pk4f8(o1[0], o1[1], o1[2], o1[3]); *(u32x2*)(act + a0) = o; } else st8bf((bf16_t*)act + a0, o0, o1);
    }
    __device__ __forceinline__ float row_scale(int, int) const { return 1.f; }
    __device__ __forceinline__ Col col(int, int) const { Col c; c.c0 = (f32x4){0.f, 0.f, 0.f, 0.f}; c.c1 = c.c0; return c; }
    __device__ __forceinline__ Side side(int, int, int, int) const { Side s; s.a = (f32x4){0.f, 0.f, 0.f, 0.f}; s.b = s.a; return s; }
    __device__ __forceinline__ float store(int row, float rs, int cb, int fq, f32x4 v0, f32x4 v1, const Side&, const Col&) const {
        const float s = rs * (UMM == 1 ? FSC : 1.0f);
        f32x4 o; o[0] = silu_(s * v0[0]) * (s * v1[0]); o[1] = silu_(s * v0[1]) * (s * v1[1]); o[2] = silu_(s * v0[2]) * (s * v1[2]); o[3] = silu_(s * v0[3]) * (s * v1[3]);
        if constexpr (DESZ_M == 1) *(unsigned*)(act + (size_t)row * EFF + (cb >> 1) + 4 * fq) = pk4f8(o[0], o[1], o[2], o[3]); else st4bf((bf16_t*)act + (size_t)row * EFF + (cb >> 1) + 4 * fq, o);
        return 0.f;
    }
};
struct EpiMoeDown {
    static constexpr bool MIDK = false, ROWSS = false, P16 = false; static constexpr int EB = 2;
    const float* sgate; bf16_t* ys;
    __device__ __forceinline__ float row_scale(int row, int) const { return sgate[row] * (DESZ_M == 1 ? FSC : 1.0f); }
    __device__ __forceinline__ Col col(int, int) const { Col c; c.c0 = (f32x4){0.f, 0.f, 0.f, 0.f}; c.c1 = c.c0; return c; }
    __device__ __forceinline__ Side side(int, int, int, int) const { Side s; s.a = (f32x4){0.f, 0.f, 0.f, 0.f}; s.b = s.a; return s; }
    __device__ __forceinline__ float store(int row, float rs, int cb, int fq, f32x4 v0, f32x4 v1, const Side&, const Col&) const {
        st4bf(ys + (size_t)row * D + cb + 4 * fq, v0 * rs); st4bf(ys + (size_t)row * D + cb + 16 + 4 * fq, v1 * rs); return 0.f;
    }
};

typedef int i32x4 __attribute__((ext_vector_type(4)));
typedef int i32x8 __attribute__((ext_vector_type(8)));
#define CAT8(x, y) __builtin_shufflevector((i32x4)(x), (i32x4)(y), 0, 1, 2, 3, 4, 5, 6, 7)
__device__ __forceinline__ void glds16(unsigned voff, const char* base, unsigned ldsaddr) {
    unsigned keep;
    asm volatile("s_mov_b32 %0, m0\n\ts_mov_b32 m0, %3\n\ts_nop 0\n\tglobal_load_lds_dwordx4 %1, %2\n\ts_mov_b32 m0, %0" : "=&s"(keep) : "v"(voff), "s"(base), "s"(ldsaddr) : "memory");
}
namespace pg8 {
constexpr int BM = 256, BK = 64, HALF = 128, HTB = HALF * BK * 2, STAGE_BYTES = 8 * HTB, NXCD = 8, WGM = 4;
__host__ __device__ __forceinline__ int lds_byte(int r, int c) { const int st = (r >> 4) * 2 + (c >> 5), rr = r & 15, cc = c & 31, ob = rr * 64 + cc * 2; return st * 1024 + (ob ^ (((ob >> 9) & 1) << 5)); }
__host__ __device__ __forceinline__ void stage_rc(int b, int& R, int& C) { const int st = b / 1024, sb = b % 1024, swz = sb ^ (((sb >> 9) & 1) << 5); R = (st >> 1) * 16 + swz / 64; C = (st & 1) * 32 + (swz % 64) / 2; }
struct Unit { int pm, pn, aux; const char* A; const char* B; const float* SB; };

struct DenseOrder {
    const char* A; const char* B; const float* SB; int nM, nN, nwg, G, c, pn0; size_t tstep;
    __device__ __forceinline__ void init(const void* A_, const void* B_, int M, int N, int K, int esz, int G_, int c_, int pn0_ = 0) { pn0 = pn0_; SB = nullptr; A = (const char*)A_; B = (const char*)B_; nM = M / BM; nN = N / BM; nwg = nM * nN; G = G_; c = c_; tstep = (size_t)BM * K * esz; }
    __device__ __forceinline__ bool next(int i, Unit& u) const {
        const long L = (long)i * G + c; if (L >= nwg) return false;
        int wgid = (int)L; { const int q = nwg / NXCD, r = nwg % NXCD, xcd = wgid % NXCD, off = wgid / NXCD; wgid = (xcd < r ? xcd * (q + 1) : r * (q + 1) + (xcd - r) * q) + off; }
        const int nig = WGM * nN, gid = wgid / nig, fm = gid * WGM, gsz = (nM - fm) < WGM ? (nM - fm) : WGM;
        u.pm = fm + ((wgid % nig) % gsz); u.pn = pn0 + (wgid % nig) / gsz; u.aux = 0; u.A = A + (size_t)u.pm * tstep; u.B = B + (size_t)u.pn * tstep; u.SB = SB ? SB + u.pn * BM : nullptr; return true;
    }
    __device__ __forceinline__ int arow(const Unit&, int r) const { return r; }
};
constexpr bool GROUPED_XCD = true;
struct GroupedOrder {
    const char* A; const char* B; const int* texp; const int* idx; size_t estride, tstepA, tstepB; int nM, nN, nwg, G, c; const float* SB; int sbstride;
    __device__ __forceinline__ bool next(int i, Unit& u) const {
        const long L = (long)i * G + c; if (L >= nwg) return false;
        int wgid = (int)L;
        if (GROUPED_XCD) { const int q = nwg / NXCD, r = nwg % NXCD, xcd = wgid % NXCD, off = wgid / NXCD; wgid = (xcd < r ? xcd * (q + 1) : r * (q + 1) + (xcd - r) * q) + off; }
        u.pm = __builtin_amdgcn_readfirstlane(wgid / nN); u.pn = __builtin_amdgcn_readfirstlane(wgid % nN); u.aux = 0;
        const int ex = __builtin_amdgcn_readfirstlane(texp[u.pm]);
        u.A = A + (size_t)u.pm * tstepA; u.B = B + (size_t)ex * estride + (size_t)u.pn * tstepB; u.SB = SB ? SB + ex * sbstride + u.pn * BM : nullptr; return true;
    }
    __device__ __forceinline__ int arow(const Unit& u, int r) const { return idx[u.pm * BM + r]; }
};

template <class E, class = void> struct WantsDrain { static constexpr bool value = false; };
template <class E> struct WantsDrain<E, decltype((void)E::DRAIN_STORES)> { static constexpr bool value = E::DRAIN_STORES; };
template <class Epi, class Sched, int MM>
__device__ __forceinline__ void gemm_phase(LAS unsigned char* lds, const int K, const int lda, const int ldb, const Sched& S, const Epi& E, int tid, const float* SA = nullptr) {
    constexpr int ESZ = (MM == 2) ? 2 : 1;
    const int wid = __builtin_amdgcn_readfirstlane(tid >> 6), lane = tid & 63, wr = wid >> 2, wc = wid & 3, fr = lane & 15, fq = lane >> 4;
    const int nt = (K * ESZ) / 128;
    unsigned voffB[2], voffA[2];
#pragma unroll
    for (int i = 0; i < 2; ++i) { int sR, sC; stage_rc(tid * 16 + i * 8192, sR, sC); voffB[i] = (unsigned)(sR * ldb * ESZ + sC * 2); voffA[i] = (unsigned)(sR * lda * ESZ + sC * 2); }
    const size_t hstepA = (size_t)HALF * lda * ESZ;
    const size_t kstep = (size_t)(BK * 2);
    const size_t hstep = (size_t)HALF * ldb * ESZ;
    const unsigned ldsw = (unsigned)wid * 1024u;
    const unsigned ldsbase = (unsigned)__builtin_amdgcn_readfirstlane((int)(unsigned)(size_t)lds) + ldsw;
    const int aoff = lds_byte(wr * 64 + fr, fq * 8), boff = lds_byte(wc * 32 + fr, fq * 8);
#define PG8_SA(b, h) (((b) * 2 + (h)) * HTB)
#define PG8_SB(b, h) ((4 + (b) * 2 + (h)) * HTB)
#define PG8_STAGE(bufoff, gbase, voff) do { _Pragma("unroll") for (int _i = 0; _i < 2; ++_i) \
        glds16((voff)[_i], (const char*)(gbase), ldsbase + (unsigned)((bufoff) + _i * 8192)); } while (0)
#define PG8_LDA(dst, b, h) do { _Pragma("unroll") for (int m = 0; m < 4; ++m) { dst[m].lo = *(const LAS i32x4*)(lds + PG8_SA(b, h) + aoff + m * 2048); dst[m].hi = *(const LAS i32x4*)(lds + PG8_SA(b, h) + aoff + m * 2048 + 1024); } } while (0)
#define PG8_LDB(dst, b, h) do { _Pragma("unroll") for (int n = 0; n < 2; ++n) { dst[n].lo = *(const LAS i32x4*)(lds + PG8_SB(b, h) + boff + n * 2048); dst[n].hi = *(const LAS i32x4*)(lds + PG8_SB(b, h) + boff + n * 2048 + 1024); } } while (0)
#define PG8_MMA(ai, bj, At, Bt) do { __builtin_amdgcn_s_setprio(1); _Pragma("unroll") for (int m = 0; m < 4; ++m) _Pragma("unroll") for (int n = 0; n < 2; ++n) { \
        if constexpr (ESZ == 2) { acc[ai][bj][m][n] = __builtin_amdgcn_mfma_f32_16x16x32_bf16((bf16x8)Bt[n].lo, (bf16x8)At[m].lo, acc[ai][bj][m][n], 0, 0, 0); \
                                  acc[ai][bj][m][n] = __builtin_amdgcn_mfma_f32_16x16x32_bf16((bf16x8)Bt[n].hi, (bf16x8)At[m].hi, acc[ai][bj][m][n], 0, 0, 0); } \
        else if constexpr (MM == 3) { acc[ai][bj][m][n] = (f32x4)__builtin_amdgcn_mfma_i32_16x16x64_i8(Bt[n].lo, At[m].lo, (i32x4)acc[ai][bj][m][n], 0, 0, 0); \
                                      acc[ai][bj][m][n] = (f32x4)__builtin_amdgcn_mfma_i32_16x16x64_i8(Bt[n].hi, At[m].hi, (i32x4)acc[ai][bj][m][n], 0, 0, 0); } \
        else acc[ai][bj][m][n] = __builtin_amdgcn_mfma_scale_f32_16x16x128_f8f6f4(Bt[n], At[m], acc[ai][bj][m][n], 0, 0, 0, 0, 0, 0); } \
        __builtin_amdgcn_s_setprio(0); } while (0)
#define PG8_WAIT_V(n) asm volatile("s_waitcnt vmcnt(" #n ")" ::: "memory")
#define PG8_WAIT_L(n) asm volatile("s_waitcnt lgkmcnt(" #n ")" ::: "memory")
#define PG8_BAR __builtin_amdgcn_s_barrier()
#define PG8_SCHED __builtin_amdgcn_sched_barrier(0)
    Unit cur, nxt; int ui = 0;
    if (!S.next(0, cur)) return;
    f32x4 acc[2][2][4][2];
#define PG8_ZERO_ACC() do { _Pragma("unroll") for (int a = 0; a < 2; ++a) _Pragma("unroll") for (int b = 0; b < 2; ++b) _Pragma("unroll") for (int m = 0; m < 4; ++m) _Pragma("unroll") for (int n = 0; n < 2; ++n) { \
        float z0, z1, z2, z3; asm volatile("v_mov_b32 %0, 0\n\tv_mov_b32 %1, 0\n\tv_mov_b32 %2, 0\n\tv_mov_b32 %3, 0" : "=v"(z0), "=v"(z1), "=v"(z2), "=v"(z3)); \
        acc[a][b][m][n] = (f32x4){z0, z1, z2, z3}; } } while (0)
    PG8_ZERO_ACC();
    i32x8 At[4], B0[2], B1[2];
    const char* cA = cur.A; const char* cB = cur.B;
    PG8_STAGE(PG8_SB(0, 0), cB, voffB); PG8_STAGE(PG8_SB(0, 1), cB + hstep, voffB); PG8_STAGE(PG8_SA(0, 0), cA, voffA); PG8_STAGE(PG8_SA(0, 1), cA + hstepA, voffA);
    if (wr == 1) PG8_BAR;
    PG8_WAIT_V(2); PG8_BAR;
    PG8_STAGE(PG8_SB(1, 0), cB + kstep, voffB); PG8_STAGE(PG8_SA(1, 0), cA + kstep, voffA); PG8_STAGE(PG8_SB(1, 1), cB + hstep + kstep, voffB);
    PG8_WAIT_V(6); PG8_BAR;
    for (;;) {
        const bool has_next = S.next(ui + 1, nxt);
        const char* nA = has_next ? nxt.A : cA; const char* nB = has_next ? nxt.B : cB;
#define PG8_KITER(t, last) do { \
            const char* a1 = cA + (size_t)((t) + 1) * kstep; \
            const char* a2 = (last) ? nA : cA + (size_t)((t) + 2) * kstep; const char* b2 = (last) ? nB : cB + (size_t)((t) + 2) * kstep; \
            const char* a3 = a2 + kstep; const char* b3 = b2 + kstep; \
            PG8_LDB(B0, 0, 0); PG8_LDB(B1, 0, 1); PG8_SCHED; PG8_LDA(At, 0, 0); PG8_STAGE(PG8_SA(1, 1), a1 + hstepA, voffA); \
            PG8_WAIT_V(8); PG8_WAIT_L(0); PG8_BAR; PG8_MMA(0, 0, At, B0); PG8_MMA(0, 1, At, B1); PG8_BAR; PG8_SCHED; \
            PG8_LDA(At, 0, 1); PG8_STAGE(PG8_SB(0, 0), b2, voffB); PG8_STAGE(PG8_SB(0, 1), b2 + hstep, voffB); PG8_STAGE(PG8_SA(0, 0), a2, voffA); \
            PG8_WAIT_V(8); PG8_WAIT_L(0); PG8_BAR; PG8_MMA(1, 0, At, B0); PG8_MMA(1, 1, At, B1); PG8_BAR; PG8_SCHED; \
            PG8_LDB(B0, 1, 0); PG8_LDB(B1, 1, 1); PG8_SCHED; PG8_LDA(At, 1, 0); PG8_STAGE(PG8_SA(0, 1), a2 + hstepA, voffA); \
            PG8_WAIT_V(8); PG8_WAIT_L(0); PG8_BAR; PG8_MMA(0, 0, At, B0); PG8_MMA(0, 1, At, B1); PG8_BAR; PG8_SCHED; \
            PG8_LDA(At, 1, 1); PG8_STAGE(PG8_SB(1, 0), b3, voffB); PG8_STAGE(PG8_SB(1, 1), b3 + hstep, voffB); PG8_STAGE(PG8_SA(1, 0), a3, voffA); \
            PG8_WAIT_V(8); PG8_WAIT_L(0); PG8_BAR; PG8_MMA(1, 0, At, B0); PG8_MMA(1, 1, At, B1); PG8_BAR; PG8_SCHED; \
        } while (0)
#pragma clang loop unroll(disable)
        for (int t = 0; t < nt; t += 2) {
            if constexpr (Epi::MIDK) {
                if (t == nt / 2) {
#pragma unroll
                    for (int ai = 0; ai < 2; ++ai)
#pragma unroll
                        for (int m = 0; m < 4; ++m) {
                            E.mid16(cur.pm * BM + ai * HALF + wr * 64 + m * 16 + fr, cur.pn, wc, fq, acc[ai][0][m][0], acc[ai][0][m][1], acc[ai][1][m][0], acc[ai][1][m][1]);
                            asm volatile("" ::: "memory");
                        }
                }
            }
            const bool last = (t == nt - 2); PG8_KITER(t, last);
        }
        if (wr == 0) PG8_BAR;
        {
            int epm = cur.pm, epn = cur.pn, eaux = cur.aux, et = wid * 64 + lane_id_now();
            asm volatile("" : "+s"(epm), "+s"(epn), "+s"(eaux), "+v"(et));
            const int elane = et & 63, fr = elane & 15, fq = elane >> 4, ewid = __builtin_amdgcn_readfirstlane(et >> 6), wr = ewid >> 2, wc = ewid & 3;
            Col cl[2];
#pragma unroll
            for (int bj = 0; bj < 2; ++bj) cl[bj] = E.col(epn * BM + bj * HALF + wc * 32, fq);
            f32x4 sb[2][2];
            if constexpr (MM == 3) {
#pragma unroll
                for (int bj = 0; bj < 2; ++bj)
#pragma unroll
                    for (int n = 0; n < 2; ++n) sb[bj][n] = *(const f32x4*)(cur.SB + bj * HALF + wc * 32 + n * 16 + 4 * fq) * (1.0f / 127.0f);
            }
            if constexpr (Epi::P16) {
                const Col16 c16 = E.col16(epn, wc, fq);
#pragma unroll
                for (int ai = 0; ai < 2; ++ai)
#pragma unroll
                    for (int mb = 0; mb < 4; mb += 2) {
                        float rsv[4];
#pragma unroll
                        for (int m = mb; m < mb + 2; ++m) { const int row = epm * BM + ai * HALF + wr * 64 + m * 16 + fr; rsv[m] = E.row_scale(row, eaux); if constexpr (MM == 3) rsv[m] *= SA[row]; }
#pragma unroll
                        for (int m = mb; m < mb + 2; ++m) {
                            const int row = epm * BM + ai * HALF + wr * 64 + m * 16 + fr;
                            f32x4 v[2][2];
#pragma unroll
                            for (int bj = 0; bj < 2; ++bj)
#pragma unroll
                                for (int n = 0; n < 2; ++n) {
                                    v[bj][n] = acc[ai][bj][m][n];
                                    if constexpr (MM == 3) { const i32x4 iv = (i32x4)v[bj][n]; v[bj][n][0] = (float)iv[0] * sb[bj][n][0]; v[bj][n][1] = (float)iv[1] * sb[bj][n][1]; v[bj][n][2] = (float)iv[2] * sb[bj][n][2]; v[bj][n][3] = (float)iv[3] * sb[bj][n][3]; }
                                }
                            E.store16(row, rsv[m], epn, wc, fq, v[0][0], v[0][1], v[1][0], v[1][1], c16);
                            asm volatile("" ::: "memory");
                        }
                    }
            } else {
#pragma unroll
            for (int ai = 0; ai < 2; ++ai) {
#pragma unroll
              for (int mb = 0; mb < 4; mb += Epi::EB) {
                float rsv[4]; Side sd[4][2];
#pragma unroll
                for (int m = mb; m < mb + Epi::EB; ++m) {
                    const int row = epm * BM + ai * HALF + wr * 64 + m * 16 + fr;
                    rsv[m] = E.row_scale(row, eaux);
                    if constexpr (MM == 3) rsv[m] *= SA[row];
#pragma unroll
                    for (int bj = 0; bj < 2; ++bj) sd[m][bj] = E.side(row, epn * BM + bj * HALF + wc * 32, fq, eaux);
                }
#pragma unroll
                for (int m = mb; m < mb + Epi::EB; ++m) {
                    const int row = epm * BM + ai * HALF + wr * 64 + m * 16 + fr;
                    float ss = 0.f;
#pragma unroll
                    for (int bj = 0; bj < 2; ++bj) {
                        f32x4 v0 = acc[ai][bj][m][0], v1 = acc[ai][bj][m][1];
                        if constexpr (MM == 3) {
                            const i32x4 i0 = (i32x4)v0, i1 = (i32x4)v1;
                            v0[0] = (float)i0[0] * sb[bj][0][0]; v0[1] = (float)i0[1] * sb[bj][0][1]; v0[2] = (float)i0[2] * sb[bj][0][2]; v0[3] = (float)i0[3] * sb[bj][0][3];
                            v1[0] = (float)i1[0] * sb[bj][1][0]; v1[1] = (float)i1[1] * sb[bj][1][1]; v1[2] = (float)i1[2] * sb[bj][1][2]; v1[3] = (float)i1[3] * sb[bj][1][3];
                        }
                        ss += E.store(row, rsv[m], epn * BM + bj * HALF + wc * 32, fq, v0, v1, sd[m][bj], cl[bj]);
                    }
                    if constexpr (Epi::ROWSS) {
                        ss += shflx(ss, elane, 16); ss += shflx(ss, elane, 32);
                        if (fq == 0) E.write_ss(row, epn * 4 + wc, ss);
                    }
                    asm volatile("" ::: "memory");
                }
              }
            }
            }
        }
        if constexpr (WantsDrain<Epi>::value) __builtin_amdgcn_s_waitcnt(0x0F70);
        if (!has_next) break;
        PG8_ZERO_ACC();
        cur = nxt; cA = nA; cB = nB; ++ui;
        if (wr == 1) PG8_BAR;
    }
    PG8_WAIT_V(0);
    PG8_BAR;
#undef PG8_SA
#undef PG8_SB
#undef PG8_STAGE
#undef PG8_LDA
#undef PG8_LDB
#undef PG8_MMA
#undef PG8_WAIT_V
#undef PG8_WAIT_L
#undef PG8_BAR
#undef PG8_SCHED
#undef PG8_KITER
#undef PG8_ZERO_ACC
}
}


template <class Epi, bool PROJ, int MM>
__device__ __forceinline__ void rider_gemm(const Frame& F, const bf16_t* A, int lda, const bf16_t* Bt, int N, int K, const Epi& E, const bf16_t* gates, bf16_t* yout, const float* SA = nullptr, const float* SB = nullptr, int ulo = 0, int uhi = -1, int rank = -1) {
    constexpr int ESZ = (MM == 2) ? 2 : 1;
    const int lane = F.lane, fr = lane & 15, fq = lane >> 4, w = F.wave;
    LAS f32x4* red = (LAS f32x4*)F.lds;
    const int kwb = (K * ESZ) >> 3;
    for (int u = ulo + (rank < 0 ? F.nblk - 1 - F.blk : rank); u < (uhi < 0 ? (N >> 6) : uhi); u += F.nblk) {
        const int n0 = u * 64;
        const char* ap = (const char*)A + (size_t)(NTOK + fr) * lda * ESZ + w * kwb + 16 * fq;
        const char* bp = (const char*)Bt + (size_t)(n0 + fr) * K * ESZ + w * kwb + 16 * fq;
        f32x4 acc[4];
#pragma unroll
        for (int ni = 0; ni < 4; ++ni) acc[ni] = zero4();
        Side psd[2]; Col pcl[2]; float prs = 1.f; f32x4 psb[2][2]; u32x2 pga[2], pgb[2];
#pragma unroll
        for (int q = 0; q < 2; ++q) { psd[q].a = zero4(); psd[q].b = psd[q].a; pcl[q].c0 = psd[q].a; pcl[q].c1 = psd[q].a; psb[q][0] = psd[q].a; psb[q][1] = psd[q].a; pga[q] = (u32x2){0u, 0u}; pgb[q] = pga[q]; }
        if (w < 2) {
            const int prow = NTOK + fr;
#pragma unroll
            for (int q = 0; q < 2; ++q) {
                if (q != w) continue;
                const int cb = n0 + 32 * q;
                if constexpr (PROJ) {
                    if (GATES8) { const int col0 = (cb >> 8) * 256 + ((cb >> 5) & 3) * 64 + fq * 16 + ((cb >> 7) & 1) * 8; const unsigned char* g8 = (const unsigned char*)gates + (size_t)prow * 2048 + col0; pga[q] = *(const u32x2*)g8; pgb[q] = *(const u32x2*)(g8 + 1024); }
                } else {
                    if constexpr (MM == 3) { psb[q][0] = *(const f32x4*)(SB + cb + 4 * fq); psb[q][1] = *(const f32x4*)(SB + cb + 16 + 4 * fq); }
                    if constexpr (!Epi::P16) { pcl[q] = E.col(cb, fq); psd[q] = E.side(prow, cb, fq, 0); }
                }
            }
            if constexpr (!PROJ) { prs = E.row_scale(prow, 0); if constexpr (MM == 3) prs *= SA[prow]; }
        }
        for (int kb0 = 0; kb0 < kwb; kb0 += 384) {
            i32x8 af[3], bf[3][4];
#pragma unroll
            for (int c = 0; c < 3; ++c) {
                const int kb = (kb0 + c * 128 < kwb) ? kb0 + c * 128 : kb0;
                af[c].lo = *(const i32x4*)(ap + kb); af[c].hi = *(const i32x4*)(ap + kb + 64);
#pragma unroll
                for (int ni = 0; ni < 4; ++ni) { bf[c][ni].lo = *(const i32x4*)(bp + (size_t)(16 * ni) * K * ESZ + kb); bf[c][ni].hi = *(const i32x4*)(bp + (size_t)(16 * ni) * K * ESZ + kb + 64); }
            }
            __builtin_amdgcn_sched_barrier(0);
#pragma unroll
            for (int c = 0; c < 3; ++c) {
                if (kb0 + c * 128 < kwb) {
#pragma unroll
                    for (int ni = 0; ni < 4; ++ni) {
                        if constexpr (MM == 2) {
                            acc[ni] = __builtin_amdgcn_mfma_f32_16x16x32_bf16((bf16x8)bf[c][ni].lo, (bf16x8)af[c].lo, acc[ni], 0, 0, 0);
                            acc[ni] = __builtin_amdgcn_mfma_f32_16x16x32_bf16((bf16x8)bf[c][ni].hi, (bf16x8)af[c].hi, acc[ni], 0, 0, 0);
                        } else if constexpr (MM == 3) {
                            acc[ni] = (f32x4)__builtin_amdgcn_mfma_i32_16x16x64_i8(bf[c][ni].lo, af[c].lo, (i32x4)acc[ni], 0, 0, 0);
                            acc[ni] = (f32x4)__builtin_amdgcn_mfma_i32_16x16x64_i8(bf[c][ni].hi, af[c].hi, (i32x4)acc[ni], 0, 0, 0);
                        } else acc[ni] = __builtin_amdgcn_mfma_scale_f32_16x16x128_f8f6f4(bf[c][ni], af[c], acc[ni], 0, 0, 0, 0, 0, 0);
                    }
                }
            }
        }
        if constexpr (MM == 3) {
#pragma unroll
            for (int ni = 0; ni < 4; ++ni) { const i32x4 iv = (i32x4)acc[ni]; acc[ni][0] = (float)iv[0]; acc[ni][1] = (float)iv[1]; acc[ni][2] = (float)iv[2]; acc[ni][3] = (float)iv[3]; }
        }
        __syncthreads();
#pragma unroll
        for (int ni = 0; ni < 4; ++ni) red[(w * 4 + ni) * 64 + lane] = acc[ni];
        __syncthreads();
        static_assert(!Epi::ROWSS, "the rider's row sums assume one epilogue wave");
        if (w < 2) {
            const int row = NTOK + fr;
            float ss = 0.f;
#pragma unroll
            for (int q = 0; q < 2; ++q) {
                if (q != w) continue;
                f32x4 v0a = zero4(), v1a = v0a, v0b = v0a, v1b = v0a;
#pragma unroll
                for (int x = 0; x < 4; ++x) { v0a += red[(x * 4 + 2 * q) * 64 + lane]; v1a += red[(x * 4 + 2 * q + 1) * 64 + lane]; v0b += red[((x + 4) * 4 + 2 * q) * 64 + lane]; v1b += red[((x + 4) * 4 + 2 * q + 1) * 64 + lane]; }
                const int cb = n0 + 32 * q;
                if constexpr (PROJ) {
                    const int col0 = (cb >> 8) * 256 + ((cb >> 5) & 3) * 64 + fq * 16 + ((cb >> 7) & 1) * 8;
                    const bf16_t* gp = gates + (size_t)row * 2048 + col0;
                    f32x4 g00, g01, g10, g11;
                    if (GATES8) { const u32x2 a = pga[q], b = pgb[q];
                        g00 = un4u8(a[0]) * (1.0f / 255.0f); g01 = un4u8(a[1]) * (1.0f / 255.0f); g10 = un4u8(b[0]) * (1.0f / 255.0f); g11 = un4u8(b[1]) * (1.0f / 255.0f); }
                    else { g00 = ld4bf(gp); g01 = ld4bf(gp + 4); g10 = ld4bf(gp + 1024); g11 = ld4bf(gp + 1024 + 4); }
                    const f32x4 y0 = g00 * v0a + g10 * v0b, y1 = g01 * v1a + g11 * v1b;
                    if (E.y8) { u32x2 o; o[0] = pk4f8(y0[0] * YSC, y0[1] * YSC, y0[2] * YSC, y0[3] * YSC); o[1] = pk4f8(y1[0] * YSC, y1[1] * YSC, y1[2] * YSC, y1[3] * YSC); *(u32x2*)((unsigned char*)yout + (size_t)row * D + col0) = o; }
                    else st8bf(yout + (size_t)row * D + col0, y0, y1);
                } else {
                    const float rs = prs;
                    f32x4 w0 = v0a + v0b, w1 = v1a + v1b;
                    if constexpr (MM == 3) { w0 = w0 * (psb[q][0] * (1.0f / 127.0f)); w1 = w1 * (psb[q][1] * (1.0f / 127.0f)); }
                    if constexpr (Epi::P16) E.rider_pair(row, rs, cb >> 8, (cb >> 7) & 1, (cb >> 5) & 3, fq, w0, w1);
                    else ss += E.store(row, rs, cb, fq, w0, w1, psd[q], pcl[q]);
                }
            }
            if constexpr (Epi::ROWSS) { ss += shflx(ss, lane, 16); ss += shflx(ss, lane, 32); if (fq == 0) E.write_ss(row, u, ss); }
        }
    }
}

template <class Epi, int MM = 2>
__device__ __forceinline__ void dense_gemm(const Frame& G, const void* A, const void* Bt, int N, int K, const Epi& E, const float* SA = nullptr, const float* SB = nullptr, const Epi* ER = nullptr, int nbody = -1, int ruhi = -1) {
    const Frame F = local_frame(G);
    pg8::DenseOrder S; S.init(A, Bt, NTOK, nbody < 0 ? N : nbody, K, (MM == 2) ? 2 : 1, F.nblk, F.blk); S.SB = SB;
    pg8::gemm_phase<Epi, pg8::DenseOrder, MM>(F.lds, K, K, K, S, E, F.tid, SA);
    const Frame R = local_frame(G);
    rider_gemm<Epi, false, MM>(R, (const bf16_t*)A, K, (const bf16_t*)Bt, N, K, ER ? *ER : E, nullptr, nullptr, SA, SB, 0, ruhi);
}


__device__ __forceinline__ void moe_router(const Frame& G, int layer, int c_lo, int c_hi);
__device__ __forceinline__ bool panel_arrive(const Frame& F, unsigned* cnt, unsigned expect, bool wait_all) {
    LAS unsigned* w = (LAS unsigned*)(F.lds + LDS_MISC_OFF + 32);
    asm volatile("s_waitcnt vmcnt(0)" ::: "memory");
    __syncthreads();
    if (F.tid == 0) {
        const unsigned old = __hip_atomic_fetch_add(cnt, 1u, __ATOMIC_RELAXED, __HIP_MEMORY_SCOPE_AGENT);
        bool done = (old + 1u == expect);
        if (wait_all && !done) {
            unsigned sp = 0;
            while (__hip_atomic_load(cnt, __ATOMIC_RELAXED, __HIP_MEMORY_SCOPE_AGENT) < expect) { __builtin_amdgcn_s_sleep(2); if (++sp > (1u << 20)) break; }
            done = true;
        }
        if (done) { __builtin_amdgcn_fence(__ATOMIC_ACQUIRE, "agent"); asm volatile("s_waitcnt vmcnt(0)" ::: "memory"); }
        *w = done ? 1u : 0u;
    }
    __syncthreads();
    const bool r = (*w != 0u);
    __syncthreads();
    return r;
}
template <int MM, int POST>
__device__ __forceinline__ void res_gemm(const Frame& G, const void* A, const void* Bt, int K, const EpiRes& E, int layer, unsigned* pcnt) {
    const Frame F = local_frame(G);
    pg8::DenseOrder S; S.init(A, Bt, NTOK, D, K, (MM == 2) ? 2 : 1, F.nblk, F.blk);
    pg8::gemm_phase<EpiRes, pg8::DenseOrder, MM>(F.lds, K, K, K, S, E, F.tid);
    if constexpr (POST != 0) {
        const Frame P = local_frame(G);
        pg8::DenseOrder S2; S2.init(A, Bt, NTOK, D, K, (MM == 2) ? 2 : 1, P.nblk, P.blk);
        for (int i = 0;; ++i) {
            pg8::Unit u; if (!S2.next(i, u)) break;
            if (panel_arrive(P, pcnt + u.pm * 16, 4u, true)) { const int r0 = u.pm * 256 + u.pn * 64; if (POST == 1) qnorm_rows(P, r0, r0 + 64); else moe_router(P, layer, u.pm * 4 + u.pn, u.pm * 4 + u.pn + 1); }
        }
    }
    const Frame R = local_frame(G);
    rider_gemm<EpiRes, false, MM>(R, (const bf16_t*)A, K, (const bf16_t*)Bt, D, K, E, nullptr, nullptr);
    if constexpr (POST != 0) {
        const Frame P = local_frame(G);
        for (int u = P.nblk - 1 - P.blk; u < (D >> 6); u += P.nblk)
            if (panel_arrive(P, pcnt + 64 * 16, (unsigned)(D >> 6), false)) { if (POST == 1) qnorm_rows(P, NTOK, NV); else moe_router(P, layer, 256, 257); }
    }
}

struct ProjOrder {
    const char* A; const char* B; int G, c;
    __device__ __forceinline__ bool next(int i, pg8::Unit& u) const {
        const int tile = c + (i >> 1) * G; if (tile >= 256) return false;
        u.pm = tile >> 2; u.pn = tile & 3; u.aux = i & 1; u.SB = nullptr;
        u.A = A + (size_t)u.pm * 256 * D * 2 + (size_t)u.aux * 512 * 2; u.B = B + (size_t)u.pn * 256 * D * 2 + (size_t)u.aux * 512 * 2; return true;
    }
    __device__ __forceinline__ int arow(const pg8::Unit&, int r) const { return r; }
};
struct EpiProj2 {
    static constexpr bool MIDK = false, ROWSS = false, P16 = false; static constexpr int EB = 2;
    const bf16_t* gates; bf16_t* y; int y8;
    __device__ __forceinline__ float row_scale(int, int aux) const { return aux ? 1.f : 0.f; }
    __device__ __forceinline__ Col col(int, int) const { Col c; c.c0 = (f32x4){0.f, 0.f, 0.f, 0.f}; c.c1 = c.c0; return c; }
    __device__ __forceinline__ Side side(int row, int cb, int fq, int aux) const {
        const bf16_t* gp = gates + (size_t)row * 2048 + aux * 1024 + cb + 4 * fq;
        Side s; s.a = bits4(*(const u32x2*)gp, *(const u32x2*)(gp + 16));
        if (aux) { const bf16_t* yp = y + (size_t)row * D + cb + 4 * fq; s.b = bits4(*(const u32x2*)yp, *(const u32x2*)(yp + 16)); } else s.b = (f32x4){0.f, 0.f, 0.f, 0.f};
        return s;
    }
    __device__ __forceinline__ float store(int row, float, int cb, int fq, f32x4 v0, f32x4 v1, const Side& s, const Col&) const {
        bf16_t* yp = y + (size_t)row * D + cb + 4 * fq;
        st4bf(yp, unpk4(s.b[0], s.b[1]) + v0 * unpk4(s.a[0], s.a[1])); st4bf(yp + 16, unpk4(s.b[2], s.b[3]) + v1 * unpk4(s.a[2], s.a[3])); return 0.f;
    }
};
__device__ __forceinline__ void ld16bf(const bf16_t* p, f32x4 (&o)[4]) { const u32x4 a = *(const u32x4*)p, b = *(const u32x4*)(p + 8);
    o[0] = unpk4(__uint_as_float(a[0]), __uint_as_float(a[1])); o[1] = unpk4(__uint_as_float(a[2]), __uint_as_float(a[3])); o[2] = unpk4(__uint_as_float(b[0]), __uint_as_float(b[1])); o[3] = unpk4(__uint_as_float(b[2]), __uint_as_float(b[3])); }
struct EpiProj3 {
    static constexpr bool MIDK = true, ROWSS = false, P16 = true; static constexpr int EB = 2;
    const bf16_t* gates; bf16_t* y; int y8;
    __device__ __forceinline__ float row_scale(int, int) const { return 1.f; }
    __device__ __forceinline__ Col col(int, int) const { Col c; c.c0 = (f32x4){0.f, 0.f, 0.f, 0.f}; c.c1 = c.c0; return c; }
    __device__ __forceinline__ Side side(int, int, int, int) const { Side s; s.a = (f32x4){0.f, 0.f, 0.f, 0.f}; s.b = s.a; return s; }
    __device__ __forceinline__ float store(int, float, int, int, f32x4, f32x4, const Side&, const Col&) const { return 0.f; }
    __device__ __forceinline__ Col16 col16(int, int, int) const { Col16 c; c.b[0] = (f32x4){0.f, 0.f, 0.f, 0.f}; c.b[1] = c.b[0]; c.b[2] = c.b[0]; c.b[3] = c.b[0]; return c; }
    __device__ __forceinline__ void mid16(int row, int pn, int wc, int fq, f32x4& v00, f32x4& v01, f32x4& v10, f32x4& v11) const {
        const int col0 = pn * 256 + wc * 64 + fq * 16;
        f32x4 g0[4], g1[4];
        if (GATES8) { ld16u8((const unsigned char*)gates + (size_t)row * 2048 + col0, g0); ld16u8((const unsigned char*)gates + (size_t)row * 2048 + 1024 + col0, g1); }
        else { ld16bf(gates + (size_t)row * 2048 + col0, g0); ld16bf(gates + (size_t)row * 2048 + 1024 + col0, g1); }
#pragma unroll
        for (int i = 0; i < 4; ++i) { v00[i] *= g0[0][i] * __builtin_amdgcn_rcpf(g1[0][i]); v01[i] *= g0[1][i] * __builtin_amdgcn_rcpf(g1[1][i]); v10[i] *= g0[2][i] * __builtin_amdgcn_rcpf(g1[2][i]); v11[i] *= g0[3][i] * __builtin_amdgcn_rcpf(g1[3][i]); }
    }
    __device__ __forceinline__ void store16(int row, float, int pn, int wc, int fq, f32x4 v00, f32x4 v01, f32x4 v10, f32x4 v11, const Col16&) const {
        const int col0 = pn * 256 + wc * 64 + fq * 16;
        f32x4 g1[4];
        if (GATES8) { ld16u8((const unsigned char*)gates + (size_t)row * 2048 + 1024 + col0, g1); g1[0] = g1[0] * (1.0f / 255.0f); g1[1] = g1[1] * (1.0f / 255.0f); g1[2] = g1[2] * (1.0f / 255.0f); g1[3] = g1[3] * (1.0f / 255.0f); }
        else ld16bf(gates + (size_t)row * 2048 + 1024 + col0, g1);
        if (y8) {
            const f32x4 a = v00 * g1[0] * YSC, b = v01 * g1[1] * YSC, c = v10 * g1[2] * YSC, d = v11 * g1[3] * YSC;
            u32x4 o; o[0] = pk4f8(a[0], a[1], a[2], a[3]); o[1] = pk4f8(b[0], b[1], b[2], b[3]); o[2] = pk4f8(c[0], c[1], c[2], c[3]); o[3] = pk4f8(d[0], d[1], d[2], d[3]);
            *(u32x4*)((unsigned char*)y + (size_t)row * D + col0) = o;
            return;
        }
        bf16_t* p = y + (size_t)row * D + col0;
        st8bf(p, v00 * g1[0], v01 * g1[1]); st8bf(p + 8, v10 * g1[2], v11 * g1[3]);
    }
};
__device__ __forceinline__ void proj_gemm(const Frame& G, const bf16_t* A, const bf16_t* Bt, const bf16_t* gates, bf16_t* y, int y8, bool meta_rows = true) {
    const Frame F = local_frame(G);
    pg8::DenseOrder S; S.init(A, Bt, NTOK, D, D, 2, F.nblk, F.blk);
    EpiProj3 E3{gates, y, y8};
    pg8::gemm_phase<EpiProj3, pg8::DenseOrder, 2>(F.lds, D, D, D, S, E3, F.tid);
    const Frame R = local_frame(G);
    EpiProj2 E2{gates, y, y8};
    if (meta_rows) rider_gemm<EpiProj2, true, 2>(R, A, D, Bt, D, D, E2, gates, y);
}

constexpr int S5_TROW = 272;
constexpr int S5_TBYTES = 128 * S5_TROW;
constexpr int S5_SC_OFF = 3 * S5_TBYTES;
constexpr int S5_SC_BYTES = 16 * S5_TROW;

template <bool D0>
__device__ __forceinline__ void s5_wave(const Frame& F, int layer, int g, int panel) {
    const int lane = F.lane, fr = lane & 15, fq = lane >> 4;
    const int row0 = panel < 64 ? panel * 256 : NTOK, nsub = panel < 64 ? 32 : 2;
    LAS unsigned char* tb = F.lds;
    LAS unsigned char* sc = F.lds + S5_SC_OFF + F.wave * S5_SC_BYTES;
    const bf16_t* us5 = WSP(bf16_t, T_US5);
    f32x2* span = WSP(f32x2, WS_SPAN);
    const f32x2 w8 = WSP(f32x2, WS_W8)[((size_t)layer * NG + g) * 64 + lane];
    float sr = 0.f, si = 0.f;
    if (D0 && panel < 64) {
        const f32x2 w256 = WSP(f32x2, WS_W256)[((size_t)layer * NG + g) * 64 + lane];
        const f32x2 sm = span[((size_t)64 * NG + g) * 64 + lane];
        sr = sm[0]; si = sm[1];
        const int b0 = (panel >> 5) << 5;
        for (int qb = b0; qb < panel; qb += 8) {
            f32x2 x[8];
#pragma unroll
            for (int i = 0; i < 8; ++i) { const int q = (qb + i < panel) ? qb + i : panel - 1; x[i] = span[((size_t)q * NG + g) * 64 + lane]; }
#pragma unroll
            for (int i = 0; i < 8; ++i) {
                if (qb + i < panel) {
                    const float nr = w256[0] * sr - w256[1] * si + x[i][0];
                    const float ni = w256[0] * si + w256[1] * sr + x[i][1];
                    sr = nr; si = ni;
                }
            }
        }
    }
    const float* dsk = F.in[12] + (size_t)layer * S5W + g * 16 + 4 * fq;
    const f32x4 dv = *(const f32x4*)dsk;
    bf16x8 ufa[2][4];
#pragma unroll
    for (int nt = 0; nt < 2; ++nt)
#pragma unroll
        for (int ks = 0; ks < 4; ++ks) {
            const int sub = nt * 16 + fr;
            const int tok = row0 + sub * 8 + 2 * ks + (fq >> 1);
            ufa[nt][ks] = (sub < nsub) ? *(const bf16x8*)(us5 + ((size_t)g * MP + tok) * 16 + (fq & 1) * 8) : (bf16x8){0, 0, 0, 0, 0, 0, 0, 0};
        }
#pragma unroll
    for (int nt = 0; nt < 2; ++nt) {
        if (nt * 16 >= nsub) break;
        const int sub = nt * 16 + fr; const bool valid = sub < nsub;
        bf16x8 uf[4];
#pragma unroll
        for (int ks = 0; ks < 4; ++ks) uf[ks] = ufa[nt][ks];
#pragma unroll
        for (int mt = 0; mt < 8; ++mt) {
            f32x4 xa = zero4();
#pragma unroll
            for (int ks = 0; ks < 4; ++ks) {
                const bf16x8 a = *(const LAS bf16x8*)(tb + (mt * 16 + fr) * S5_TROW + (ks * 32 + fq * 8) * 2);
                xa = __builtin_amdgcn_mfma_f32_16x16x32_bf16(a, uf[ks], xa, 0, 0, 0);
            }
            u32x2 o; o[0] = pk2(xa[0], xa[1]); o[1] = pk2(xa[2], xa[3]);
            *(LAS u32x2*)(sc + fr * S5_TROW + (mt * 16 + 4 * fq) * 2) = o;
        }
        asm volatile("s_waitcnt lgkmcnt(0)" ::: "memory");
        const int nj = (nsub - nt * 16) < 16 ? (nsub - nt * 16) : 16;
        for (int j = 0; j < nj; ++j) {
            LAS bf16_t* rowp = (LAS bf16_t*)(sc + j * S5_TROW);
            const float xr = bf2f(rowp[lane]), xi = bf2f(rowp[64 + lane]);
            if (D0) { rowp[lane] = f2bf(sr); rowp[64 + lane] = f2bf(si); }
            const float nr = w8[0] * sr - w8[1] * si + xr;
            const float ni = w8[0] * si + w8[1] * sr + xi;
            sr = nr; si = ni;
        }
        asm volatile("s_waitcnt lgkmcnt(0)" ::: "memory");
        if (D0) {
            bf16x8 sf[4];
#pragma unroll
            for (int ks = 0; ks < 4; ++ks) sf[ks] = *(const LAS bf16x8*)(sc + fr * S5_TROW + (ks * 32 + fq * 8) * 2);
            bf16_t* ys5 = WSP(bf16_t, T_YS5);
            u32x2 uraw[8];
#pragma unroll
            for (int mt = 0; mt < 8; ++mt) uraw[mt] = valid ? *(const u32x2*)(us5 + ((size_t)g * MP + (row0 + sub * 8 + mt)) * 16 + 4 * fq) : (u32x2){0u, 0u};
#pragma unroll
            for (int mt = 0; mt < 8; ++mt) {
                f32x4 ya = zero4();
#pragma unroll
                for (int ks = 0; ks < 4; ++ks) {
                    const bf16x8 a = *(const LAS bf16x8*)(tb + S5_TBYTES + (mt * 16 + fr) * S5_TROW + (ks * 32 + fq * 8) * 2);
                    ya = __builtin_amdgcn_mfma_f32_16x16x32_bf16(a, uf[ks], ya, 0, 0, 0);
                }
#pragma unroll
                for (int ks = 0; ks < 4; ++ks) {
                    const bf16x8 a = *(const LAS bf16x8*)(tb + 2 * S5_TBYTES + (mt * 16 + fr) * S5_TROW + (ks * 32 + fq * 8) * 2);
                    ya = __builtin_amdgcn_mfma_f32_16x16x32_bf16(a, sf[ks], ya, 0, 0, 0);
                }
                if (valid) {
                    const int tok = row0 + sub * 8 + mt, ch = g * 16 + 4 * fq;
                    const f32x4 u = unpk4(__uint_as_float(uraw[mt][0]), __uint_as_float(uraw[mt][1]));
                    f32x4 o; o[0] = gelu_tanh(ya[0] + dv[0] * u[0]); o[1] = gelu_tanh(ya[1] + dv[1] * u[1]); o[2] = gelu_tanh(ya[2] + dv[2] * u[2]); o[3] = gelu_tanh(ya[3] + dv[3] * u[3]);
                    st4bf(ys5 + (size_t)tok * 512 + ch, o);
                }
            }
            asm volatile("s_waitcnt lgkmcnt(0)" ::: "memory");
        }
    }
    if (!D0) { f32x2 o; o[0] = sr; o[1] = si; span[((size_t)panel * NG + g) * 64 + lane] = o; }
}
template <bool D0>
__device__ __forceinline__ void s5_phase(const Frame& G, int layer) {
    const Frame F = local_frame(G);
    for (int wu = F.blk; wu < NG * 9; wu += F.nblk) {
        const int g = wu % NG, oct = wu / NG;
        __syncthreads();
        const bf16_t* T = WSP(bf16_t, WS_S5T) + ((size_t)layer * NG + g) * 3 * 16384;
        for (int i = F.tid; i < 3 * 128 * 16; i += NTHREADS) {
            const int tbl = i >> 11, r = (i >> 4) & 127, c = i & 15;
            if (D0 || tbl == 0) *(LAS u32x4*)(F.lds + tbl * S5_TBYTES + r * S5_TROW + c * 16) = *(const u32x4*)(T + (size_t)tbl * 16384 + r * 128 + c * 8);
        }
        __syncthreads();
        const int panel = oct < 8 ? oct * 8 + F.wave : (F.wave == 0 ? 64 : -1);
        if (panel >= 0) s5_wave<D0>(F, layer, g, panel);
    }
}

constexpr int LRU_XROW = 144;
constexpr int LRU_VROW = 68;
constexpr int LRU_OFF_AV = 128 * LRU_XROW;
constexpr int LRU_OFF_BV = LRU_OFF_AV + 128 * LRU_VROW * 4;
constexpr int LRU_OFF_AGG = LRU_OFF_BV + 128 * LRU_VROW * 4;
constexpr int LRU_OFF_CST = LRU_OFF_AGG + 8 * 64 * 8;
constexpr int LRU_OFF_CAR = LRU_OFF_CST + 64 * 16;
template <bool D0>
__device__ __forceinline__ void lru_unit(const Frame& G, int layer, int panel, int head) {
    const Frame F = local_frame(G);
    const int tid = F.tid, lane = F.lane, fr = lane & 15, fq = lane >> 4;
    LAS unsigned char* xcb = F.lds;
    LAS float* av = (LAS float*)(F.lds + LRU_OFF_AV);
    LAS float* bv = (LAS float*)(F.lds + LRU_OFF_BV);
    LAS f32x2* agg = (LAS f32x2*)(F.lds + LRU_OFF_AGG);
    LAS f32x4* cst = (LAS f32x4*)(F.lds + LRU_OFF_CST);
    LAS f32x2* car = (LAS f32x2*)(F.lds + LRU_OFF_CAR);
    const int row0 = panel < 64 ? panel * 256 : NTOK, ntok = panel < 64 ? 256 : 16;
    const bf16_t* xl = WSP(bf16_t, T_XLRU);
    const float* apan = WSP(float, WS_APAN); const float* hpan = WSP(float, WS_HPAN);
    __syncthreads();
    if (tid < 64) {
        const int ch = head * 64 + tid;
        const float lam = F.in[22][(size_t)layer * 512 + ch];
        f32x4 c; c[0] = F.in[19][(size_t)layer * 512 + ch]; c[1] = F.in[21][(size_t)layer * 512 + ch]; { const float x = __expf(-lam); c[2] = (x < 0.05f) ? x * (1.0f - x * (0.5f - x * (0.33333334f - 0.25f * x))) : ((-lam > 20.f) ? -lam : __logf(1.0f + x)); } c[3] = 0.f;
        cst[tid] = c;
    }
    if (D0 && panel < 64) {
        const int c = tid & 63, jg = tid >> 6, ch = head * 64 + c, b0 = (panel >> 5) << 5;
        float A = 1.f, H = 0.f;
#pragma unroll
        for (int q4 = 0; q4 < 4; ++q4) {
            const int q = b0 + jg * 4 + q4;
            if (q < panel) { const float a = apan[q * 512 + ch], h = hpan[q * 512 + ch]; H = a * H + h; A *= a; }
        }
        f32x2 o; o[0] = A; o[1] = H; agg[jg * 64 + c] = o;
        __syncthreads();
        if (tid < 64) {
            float h = hpan[64 * 512 + ch];
#pragma unroll
            for (int j = 0; j < 8; ++j) { const f32x2 g = agg[j * 64 + c]; h = g[0] * h + g[1]; }
            { float one = 1.f; OPAQUE(one); f32x2 o2; o2[0] = h; o2[1] = one; car[c] = o2; }
        }
    } else if (tid < 64) { float z = 0.f; OPAQUE(z); f32x2 o2; o2[0] = z; o2[1] = z + 1.f; car[tid] = o2; }
    bf16x8 wf[2][4][2];
    {
        const bf16_t* lw = WSP(bf16_t, WS_LRUW) + ((size_t)(layer * 8 + head) * 2) * 4096;
#pragma unroll
        for (int g = 0; g < 2; ++g)
#pragma unroll
            for (int nb = 0; nb < 4; ++nb)
#pragma unroll
                for (int ks = 0; ks < 2; ++ks) wf[g][nb][ks] = *(const bf16x8*)(lw + (size_t)g * 4096 + (nb * 16 + fr) * 64 + ks * 32 + fq * 8);
    }
    const int c8 = (tid & 7) * 8;
    float cw[4][8], cbv[8];
#pragma unroll
    for (int w = 0; w < 4; ++w) {
        const f32x4 u0 = *(const f32x4*)(F.in[16] + ((size_t)layer * 4 + w) * 512 + head * 64 + c8), u1 = *(const f32x4*)(F.in[16] + ((size_t)layer * 4 + w) * 512 + head * 64 + c8 + 4);
        cw[w][0] = u0[0]; cw[w][1] = u0[1]; cw[w][2] = u0[2]; cw[w][3] = u0[3]; cw[w][4] = u1[0]; cw[w][5] = u1[1]; cw[w][6] = u1[2]; cw[w][7] = u1[3];
    }
    {
        const f32x4 u0 = *(const f32x4*)(F.in[17] + (size_t)layer * 512 + head * 64 + c8), u1 = *(const f32x4*)(F.in[17] + (size_t)layer * 512 + head * 64 + c8 + 4);
        cbv[0] = u0[0]; cbv[1] = u0[1]; cbv[2] = u0[2]; cbv[3] = u0[3]; cbv[4] = u1[0]; cbv[5] = u1[1]; cbv[6] = u1[2]; cbv[7] = u1[3];
    }
    u32x4 xr[2][4];
#define LRU_LOADX(T0, NREM) do { _Pragma("unroll") for (int _ps = 0; _ps < 2; ++_ps) _Pragma("unroll") for (int _w = 0; _w < 4; ++_w) { \
        const int _t = _ps * 64 + (tid >> 3), _tok = (T0) + _t - 3 + _w; bool _have = _t < (NREM); size_t _row; \
        if (_tok >= 0) _row = (size_t)(row0 + _tok); else if (panel >= 64) { _have = false; _row = 0; } else if ((panel & 31) == 0) _row = (size_t)(NTOK + NMETA + _tok); else _row = (size_t)(row0 + _tok); \
        xr[_ps][_w] = _have ? *(const u32x4*)(xl + _row * 512 + head * 64 + c8) : (u32x4){0u, 0u, 0u, 0u}; } } while (0)
    LRU_LOADX(0, ntok);
    int half = 0;
    for (int t0 = 0; t0 < ntok; t0 += 128, ++half) {
        const int nth = (ntok - t0) < 128 ? (ntok - t0) : 128;
        u32x4 gvv[2];
        if (D0) {
            const int t4 = tid >> 2;
            const bf16_t* gg = WSP(bf16_t, T_GG) + (size_t)(row0 + t0 + (t4 < nth ? t4 : 0)) * 512 + head * 64 + (tid & 3) * 16;
#pragma unroll
            for (int q = 0; q < 2; ++q) gvv[q] = *(const u32x4*)(gg + q * 8);
        }
#pragma unroll
        for (int ps = 0; ps < 2; ++ps) {
            const int t = ps * 64 + (tid >> 3);
            float xc[8];
#pragma unroll
            for (int i = 0; i < 8; ++i) xc[i] = cbv[i];
#pragma unroll
            for (int w = 0; w < 4; ++w) {
                const u32x4 v = xr[ps][w];
#pragma unroll
                for (int i = 0; i < 4; ++i) { xc[2 * i] += cw[w][2 * i] * __uint_as_float(v[i] << 16); xc[2 * i + 1] += cw[w][2 * i + 1] * __uint_as_float(v[i] & 0xffff0000u); }
            }
            if (t >= nth) {
#pragma unroll
                for (int i = 0; i < 8; ++i) xc[i] = 0.f;
            }
            u32x4 o; o[0] = pk2(xc[0], xc[1]); o[1] = pk2(xc[2], xc[3]); o[2] = pk2(xc[4], xc[5]); o[3] = pk2(xc[6], xc[7]);
            *(LAS u32x4*)(xcb + t * LRU_XROW + c8 * 2) = o;
        }
        if (t0 + 128 < ntok) { LRU_LOADX(t0 + 128, ntok - t0 - 128); }
        __syncthreads();
        {
            const int tk = F.wave * 16 + fr;
            bf16x8 xf[2];
#pragma unroll
            for (int ks = 0; ks < 2; ++ks) xf[ks] = *(const LAS bf16x8*)(xcb + tk * LRU_XROW + (ks * 32 + fq * 8) * 2);
#pragma unroll
            for (int nb = 0; nb < 4; ++nb) {
                f32x4 ar = zero4(), ai = zero4();
#pragma unroll
                for (int ks = 0; ks < 2; ++ks) { ar = __builtin_amdgcn_mfma_f32_16x16x32_bf16(wf[0][nb][ks], xf[ks], ar, 0, 0, 0); ai = __builtin_amdgcn_mfma_f32_16x16x32_bf16(wf[1][nb][ks], xf[ks], ai, 0, 0, 0); }
                const int ch = nb * 16 + 4 * fq;
                const u32x2 xv = *(const LAS u32x2*)(xcb + tk * LRU_XROW + ch * 2);
                float xcv[4]; xcv[0] = __uint_as_float(xv[0] << 16); xcv[1] = __uint_as_float(xv[0] & 0xffff0000u); xcv[2] = __uint_as_float(xv[1] << 16); xcv[3] = __uint_as_float(xv[1] & 0xffff0000u);
                f32x4 ao, bo;
#pragma unroll
                for (int r = 0; r < 4; ++r) {
                    const f32x4 c = cst[ch + r];
                    const float rg = sigmoidf_(ar[r] + c[0]), ig = sigmoidf_(ai[r] + c[1]);
                    const float la = -8.0f * rg * c[2];
                    ao[r] = (tk < nth) ? __expf(la) : 1.0f;
                    bo[r] = (tk < nth) ? __builtin_amdgcn_sqrtf(one_minus_exp(2.0f * la)) * (ig * xcv[r]) : 0.0f;
                }
                *(LAS f32x4*)(av + tk * LRU_VROW + ch) = ao;
                *(LAS f32x4*)(bv + tk * LRU_VROW + ch) = bo;
            }
        }
        __syncthreads();
        {
            const int c = tid & 63, seg = tid >> 6;
            float A = 1.f, H = 0.f;
#pragma unroll
            for (int t = 0; t < 16; ++t) { const float a = av[(seg * 16 + t) * LRU_VROW + c]; H = a * H + bv[(seg * 16 + t) * LRU_VROW + c]; A *= a; }
            f32x2 o; o[0] = A; o[1] = H; agg[seg * 64 + c] = o;
            __syncthreads();
            const f32x2 cin = car[(half & 1) * 64 + c];
            float h = cin[0], P = cin[1];
            if (D0) {
                for (int s = 0; s < seg; ++s) { const f32x2 g = agg[s * 64 + c]; h = g[0] * h + g[1]; }
#pragma unroll
                for (int t = 0; t < 16; ++t) { h = av[(seg * 16 + t) * LRU_VROW + c] * h + bv[(seg * 16 + t) * LRU_VROW + c]; bv[(seg * 16 + t) * LRU_VROW + c] = h; }
                if (seg == 7) { float one = 1.f; OPAQUE(one); f32x2 o2; o2[0] = h; o2[1] = one; car[((half + 1) & 1) * 64 + c] = o2; }
            } else if (seg == 7) {
#pragma unroll
                for (int s = 0; s < 8; ++s) { const f32x2 g = agg[s * 64 + c]; h = g[0] * h + g[1]; P *= g[0]; }
                f32x2 o2; o2[0] = h; o2[1] = P; car[((half + 1) & 1) * 64 + c] = o2;
            }
        }
        __syncthreads();
        if (D0) {
            const int t = tid >> 2, c16 = (tid & 3) * 16;
            if (t < nth) {
                const size_t row = (size_t)(row0 + t0 + t);
                bf16_t* so = WSP(bf16_t, T_SOLO) + row * D + 512 + head * 64 + c16;
#pragma unroll
                for (int q = 0; q < 2; ++q) {
                    const u32x4 gv = gvv[q];
                    const f32x4 h0 = *(const LAS f32x4*)(bv + t * LRU_VROW + c16 + q * 8), h1 = *(const LAS f32x4*)(bv + t * LRU_VROW + c16 + q * 8 + 4);
                    u32x4 o;
                    o[0] = pk2(h0[0] * __uint_as_float(gv[0] << 16), h0[1] * __uint_as_float(gv[0] & 0xffff0000u));
                    o[1] = pk2(h0[2] * __uint_as_float(gv[1] << 16), h0[3] * __uint_as_float(gv[1] & 0xffff0000u));
                    o[2] = pk2(h1[0] * __uint_as_float(gv[2] << 16), h1[1] * __uint_as_float(gv[2] & 0xffff0000u));
                    o[3] = pk2(h1[2] * __uint_as_float(gv[3] << 16), h1[3] * __uint_as_float(gv[3] & 0xffff0000u));
                    *(u32x4*)(so + q * 8) = o;
                }
            }
        }
    }
    if (!D0) {
        __syncthreads();
        if (tid < 64) { const f32x2 o = car[(half & 1) * 64 + tid]; WSP(float, WS_APAN)[panel * 512 + head * 64 + tid] = o[1]; WSP(float, WS_HPAN)[panel * 512 + head * 64 + tid] = o[0]; }
    }
}


#define RLX_AGENT __ATOMIC_RELAXED, __HIP_MEMORY_SCOPE_AGENT
constexpr unsigned LB_SPIN_CAP = 1u << 22;
__device__ __forceinline__ void lb_publish64(unsigned long long* pay, unsigned long long v, unsigned* flag, unsigned epoch, int lane) {
    __hip_atomic_store(pay + lane, v, RLX_AGENT);
    asm volatile("s_waitcnt vmcnt(0)" ::: "memory");
    if (lane == 0) __hip_atomic_store(flag, epoch, RLX_AGENT);
}
__device__ __forceinline__ void lb_wait(const unsigned* myflag, bool need, unsigned epoch) {
    unsigned sp = 0;
    for (;;) {
        const bool ok = !need || __hip_atomic_load(myflag, RLX_AGENT) >= epoch;
        if (__all(ok)) break;
        __builtin_amdgcn_s_sleep(2);
        if (++sp > LB_SPIN_CAP) break;
    }
}
__device__ __forceinline__ f32x2 lb_load2(const f32x2* p) { const unsigned long long b = __hip_atomic_load((const unsigned long long*)p, RLX_AGENT); f32x2 r; r[0] = __uint_as_float((unsigned)b); r[1] = __uint_as_float((unsigned)(b >> 32)); return r; }
__device__ __forceinline__ void lb_load2x8(const f32x2* p0, const f32x2* p1, const f32x2* p2, const f32x2* p3, const f32x2* p4, const f32x2* p5, const f32x2* p6, const f32x2* p7, f32x2 (&o)[8]) {
    unsigned long long r0, r1, r2, r3, r4, r5, r6, r7;
    asm volatile("global_load_dwordx2 %0, %8, off sc1\n\tglobal_load_dwordx2 %1, %9, off sc1\n\tglobal_load_dwordx2 %2, %10, off sc1\n\tglobal_load_dwordx2 %3, %11, off sc1\n\t"
                 "global_load_dwordx2 %4, %12, off sc1\n\tglobal_load_dwordx2 %5, %13, off sc1\n\tglobal_load_dwordx2 %6, %14, off sc1\n\tglobal_load_dwordx2 %7, %15, off sc1\n\t"
                 "s_waitcnt vmcnt(0)"
                 : "=&v"(r0), "=&v"(r1), "=&v"(r2), "=&v"(r3), "=&v"(r4), "=&v"(r5), "=&v"(r6), "=&v"(r7)
                 : "v"(p0), "v"(p1), "v"(p2), "v"(p3), "v"(p4), "v"(p5), "v"(p6), "v"(p7) : "memory");
    const unsigned long long r[8] = {r0, r1, r2, r3, r4, r5, r6, r7};
#pragma unroll
    for (int i = 0; i < 8; ++i) { o[i][0] = __uint_as_float((unsigned)r[i]); o[i][1] = __uint_as_float((unsigned)(r[i] >> 32)); }
}
__device__ __forceinline__ unsigned long long pack2(float a, float b) { return (unsigned long long)__float_as_uint(a) | ((unsigned long long)__float_as_uint(b) << 32); }
__device__ __forceinline__ unsigned short f2h(float x) { return __builtin_bit_cast(unsigned short, (_Float16)x); }
__device__ __forceinline__ float h2f(unsigned short h) { return (float)__builtin_bit_cast(_Float16, h); }

constexpr int LSP_OFF_AV = 128 * LRU_XROW;
constexpr int LSP_OFF_BV = LSP_OFF_AV + 2 * 128 * LRU_VROW * 4;
constexpr int LSP_BROW = 144;
constexpr int LSP_OFF_AGG = LSP_OFF_BV + 2 * 128 * LSP_BROW;
constexpr int LSP_OFF_CST = LSP_OFF_AGG + 16 * 64 * 8;
constexpr int LSP_OFF_CAR = LSP_OFF_CST + 64 * 16;
constexpr int LSP_OFF_GRP = LSP_OFF_CAR + 64 * 8;
static_assert(LSP_OFF_GRP + 8 * 64 * 8 <= 147392 - 64, "lru lds");
#define LRU_LOADXW(T0, NREM) do { _Pragma("unroll") for (int _ps = 0; _ps < 2; ++_ps) _Pragma("unroll") for (int _w = 0; _w < 4; ++_w) { \
        const int _t = (tid >> 6) * 16 + _ps * 8 + ((tid >> 3) & 7), _tok = (T0) + _t - 3 + _w; bool _have = _t < (NREM); size_t _row; \
        if (_tok >= 0) _row = (size_t)(row0 + _tok); else if (panel >= 64) { _have = false; _row = 0; } else if ((panel & 31) == 0) _row = (size_t)(NTOK + NMETA + _tok); else _row = (size_t)(row0 + _tok); \
        xr[_ps][_w] = _have ? *(const u32x4*)(xl + _row * 512 + head * 64 + c8) : (u32x4){0u, 0u, 0u, 0u}; } } while (0)
__device__ __forceinline__ void lru_unit_sp(const Frame& G, int layer, int panel, int head) {
    const Frame F = local_frame(G);
    const int tid = F.tid, lane = F.lane, fr = lane & 15, fq = lane >> 4;
    LAS unsigned char* xcb = F.lds;
    LAS float* avb = (LAS float*)(F.lds + LSP_OFF_AV);
    LAS unsigned char* bvb = F.lds + LSP_OFF_BV;
    LAS f32x2* agg = (LAS f32x2*)(F.lds + LSP_OFF_AGG);
    LAS f32x4* cst = (LAS f32x4*)(F.lds + LSP_OFF_CST);
    LAS float* car = (LAS float*)(F.lds + LSP_OFF_CAR);
    LAS f32x2* grp = (LAS f32x2*)(F.lds + LSP_OFF_GRP);
    const int row0 = panel < 64 ? panel * 256 : NTOK, ntok = panel < 64 ? 256 : 16, nh = panel < 64 ? 2 : 1;
    const bf16_t* xl = WSP(bf16_t, T_XLRU);
    f32x2* lpay = WSP(f32x2, WS_APAN);
    unsigned* lflag = (unsigned*)(GAS unsigned*)(F.ws + WS_LFLAG);
    const unsigned epoch = (unsigned)layer + 1u;
    __syncthreads();
    if (tid < 64) {
        const int ch = head * 64 + tid;
        const float lam = F.in[22][(size_t)layer * 512 + ch];
        f32x4 c; c[0] = F.in[19][(size_t)layer * 512 + ch]; c[1] = F.in[21][(size_t)layer * 512 + ch];
        { const float x = __expf(-lam); c[2] = (x < 0.05f) ? x * (1.0f - x * (0.5f - x * (0.33333334f - 0.25f * x))) : ((-lam > 20.f) ? -lam : __logf(1.0f + x)); } c[3] = 0.f;
        cst[tid] = c;
    }
    bf16x8 wf[2][4][2];
    {
        const bf16_t* lw = WSP(bf16_t, WS_LRUW) + ((size_t)(layer * 8 + head) * 2) * 4096;
#pragma unroll
        for (int g = 0; g < 2; ++g)
#pragma unroll
            for (int nb = 0; nb < 4; ++nb)
#pragma unroll
                for (int ks = 0; ks < 2; ++ks) wf[g][nb][ks] = *(const bf16x8*)(lw + (size_t)g * 4096 + (nb * 16 + fr) * 64 + ks * 32 + fq * 8);
    }
    const int c8 = (tid & 7) * 8;
    float cw[4][8], cbv[8];
#pragma unroll
    for (int w = 0; w < 4; ++w) {
        const f32x4 u0 = *(const f32x4*)(F.in[16] + ((size_t)layer * 4 + w) * 512 + head * 64 + c8), u1 = *(const f32x4*)(F.in[16] + ((size_t)layer * 4 + w) * 512 + head * 64 + c8 + 4);
        cw[w][0] = u0[0]; cw[w][1] = u0[1]; cw[w][2] = u0[2]; cw[w][3] = u0[3]; cw[w][4] = u1[0]; cw[w][5] = u1[1]; cw[w][6] = u1[2]; cw[w][7] = u1[3];
    }
    {
        const f32x4 u0 = *(const f32x4*)(F.in[17] + (size_t)layer * 512 + head * 64 + c8), u1 = *(const f32x4*)(F.in[17] + (size_t)layer * 512 + head * 64 + c8 + 4);
        cbv[0] = u0[0]; cbv[1] = u0[1]; cbv[2] = u0[2]; cbv[3] = u0[3]; cbv[4] = u1[0]; cbv[5] = u1[1]; cbv[6] = u1[2]; cbv[7] = u1[3];
    }
    u32x4 xr[2][4];
    LRU_LOADXW(0, ntok);
    for (int half = 0; half < nh; ++half) {
        const int t0 = half * 128, nth = (ntok - t0) < 128 ? (ntok - t0) : 128;
        LAS float* av = avb + half * 128 * LRU_VROW;
        LAS unsigned char* bv = bvb + half * 128 * LSP_BROW;
#pragma unroll
        for (int ps = 0; ps < 2; ++ps) {
            const int t = (tid >> 6) * 16 + ps * 8 + ((tid >> 3) & 7);
            float xc[8];
#pragma unroll
            for (int i = 0; i < 8; ++i) xc[i] = cbv[i];
#pragma unroll
            for (int w = 0; w < 4; ++w) {
                const u32x4 v = xr[ps][w];
#pragma unroll
                for (int i = 0; i < 4; ++i) { xc[2 * i] += cw[w][2 * i] * __uint_as_float(v[i] << 16); xc[2 * i + 1] += cw[w][2 * i + 1] * __uint_as_float(v[i] & 0xffff0000u); }
            }
            if (t >= nth) {
#pragma unroll
                for (int i = 0; i < 8; ++i) xc[i] = 0.f;
            }
            u32x4 o; o[0] = pk2(xc[0], xc[1]); o[1] = pk2(xc[2], xc[3]); o[2] = pk2(xc[4], xc[5]); o[3] = pk2(xc[6], xc[7]);
            *(LAS u32x4*)(xcb + t * LRU_XROW + c8 * 2) = o;
        }
        if (half + 1 < nh) { LRU_LOADXW(t0 + 128, ntok - t0 - 128); }
        if (half == 0) __syncthreads();
        {
            const int tk = F.wave * 16 + fr;
            bf16x8 xf[2];
#pragma unroll
            for (int ks = 0; ks < 2; ++ks) xf[ks] = *(const LAS bf16x8*)(xcb + tk * LRU_XROW + (ks * 32 + fq * 8) * 2);
#pragma unroll
            for (int nb = 0; nb < 4; ++nb) {
                f32x4 ar = zero4(), ai = zero4();
#pragma unroll
                for (int ks = 0; ks < 2; ++ks) { ar = __builtin_amdgcn_mfma_f32_16x16x32_bf16(wf[0][nb][ks], xf[ks], ar, 0, 0, 0); ai = __builtin_amdgcn_mfma_f32_16x16x32_bf16(wf[1][nb][ks], xf[ks], ai, 0, 0, 0); }
                const int ch = nb * 16 + 4 * fq;
                const u32x2 xv = *(const LAS u32x2*)(xcb + tk * LRU_XROW + ch * 2);
                float xcv[4]; xcv[0] = __uint_as_float(xv[0] << 16); xcv[1] = __uint_as_float(xv[0] & 0xffff0000u); xcv[2] = __uint_as_float(xv[1] << 16); xcv[3] = __uint_as_float(xv[1] & 0xffff0000u);
                f32x4 ao; float bo[4];
#pragma unroll
                for (int r = 0; r < 4; ++r) {
                    const f32x4 c = cst[ch + r];
                    const float rg = sigmoidf_(ar[r] + c[0]), ig = sigmoidf_(ai[r] + c[1]);
                    const float la = -8.0f * rg * c[2];
                    ao[r] = (tk < nth) ? __expf(la) : 1.0f;
                    bo[r] = (tk < nth) ? __builtin_amdgcn_sqrtf(one_minus_exp(2.0f * la)) * (ig * xcv[r]) : 0.0f;
                }
                *(LAS f32x4*)(av + tk * LRU_VROW + ch) = ao;
                u32x2 bh; bh[0] = (unsigned)f2h(bo[0]) | ((unsigned)f2h(bo[1]) << 16); bh[1] = (unsigned)f2h(bo[2]) | ((unsigned)f2h(bo[3]) << 16);
                *(LAS u32x2*)(bv + tk * LSP_BROW + ch * 2) = bh;
            }
        }
        {
            const int c = tid & 63, seg = tid >> 6;
            float A = 1.f, H = 0.f;
#pragma unroll
            for (int t = 0; t < 16; ++t) { const float a = av[(seg * 16 + t) * LRU_VROW + c]; H = a * H + h2f(*(const LAS unsigned short*)(bv + (seg * 16 + t) * LSP_BROW + c * 2)); A *= a; }
            f32x2 o; o[0] = A; o[1] = H; agg[(half * 8 + seg) * 64 + c] = o;
        }
    }
    __syncthreads();
    if (F.wave == 0) {
        float A = 1.f, H = 0.f;
        for (int s = 0; s < nh * 8; ++s) { const f32x2 g = agg[s * 64 + lane]; H = g[0] * H + g[1]; A *= g[0]; }
        lb_publish64((unsigned long long*)(lpay + (size_t)panel * 512 + head * 64), pack2(A, H), lflag + (size_t)(panel * 8 + head) * 16, epoch, lane);
        if (panel < 64) {
            const int b0 = (panel >> 5) << 5, q = (lane < 32) ? b0 + lane : 64;
            const bool need = (lane < 32) ? (q < panel) : (lane == 32);
            lb_wait(lflag + (size_t)(q * 8 + head) * 16, need, epoch);
        }
    }
    __syncthreads();
    if (panel < 64) {
        const int c = tid & 63, jg = tid >> 6, b0 = (panel >> 5) << 5;
        float A = 1.f, H = 0.f;
        f32x2 xg[8];
        {
            const f32x2* pp[8];
#pragma unroll
            for (int q4 = 0; q4 < 8; ++q4) { const int q = b0 + jg * 4 + (q4 & 3); pp[q4] = lpay + (size_t)((q4 < 4 && q < panel) ? q : 64) * 512 + head * 64 + c; }
            lb_load2x8(pp[0], pp[1], pp[2], pp[3], pp[4], pp[5], pp[6], pp[7], xg);
        }
#pragma unroll
        for (int q4 = 0; q4 < 4; ++q4) {
            const int q = b0 + jg * 4 + q4;
            if (q < panel) { const f32x2 g = xg[q4]; H = g[0] * H + g[1]; A *= g[0]; }
        }
        f32x2 o; o[0] = A; o[1] = H; grp[jg * 64 + c] = o;
        __syncthreads();
        if (tid < 64) {
            float h = xg[4][1];
#pragma unroll
            for (int j = 0; j < 8; ++j) { const f32x2 g = grp[j * 64 + c]; h = g[0] * h + g[1]; }
            car[c] = h;
        }
    } else if (tid < 64) { float z = 0.f; OPAQUE(z); car[tid] = z; }
    __syncthreads();
    for (int half = 0; half < nh; ++half) {
        const int t0 = half * 128, nth = (ntok - t0) < 128 ? (ntok - t0) : 128;
        LAS float* av = avb + half * 128 * LRU_VROW;
        LAS unsigned char* bv = bvb + half * 128 * LSP_BROW;
        u32x4 gvv[2];
        {
            const int t4 = tid >> 2;
            const bf16_t* gg = WSP(bf16_t, T_GG) + (size_t)(row0 + t0 + (t4 < nth ? t4 : 0)) * 512 + head * 64 + (tid & 3) * 16;
#pragma unroll
            for (int q = 0; q < 2; ++q) gvv[q] = *(const u32x4*)(gg + q * 8);
        }
        {
            const int c = tid & 63, seg = tid >> 6;
            float h = car[c];
            for (int s = 0; s < half * 8 + seg; ++s) { const f32x2 g = agg[s * 64 + c]; h = g[0] * h + g[1]; }
#pragma unroll
            for (int t = 0; t < 16; ++t) {
                LAS unsigned short* bp = (LAS unsigned short*)(bv + (seg * 16 + t) * LSP_BROW + c * 2);
                h = av[(seg * 16 + t) * LRU_VROW + c] * h + h2f(*bp); *bp = f2h(h);
            }
        }
        {
            const int t = tid >> 2, c16 = (tid & 3) * 16;
            if (t < nth) {
                const size_t row = (size_t)(row0 + t0 + t);
                bf16_t* so = WSP(bf16_t, T_SOLO) + row * D + 512 + head * 64 + c16;
#pragma unroll
                for (int q = 0; q < 2; ++q) {
                    const u32x4 gv = gvv[q];
                    const u32x4 hv = *(const LAS u32x4*)(bv + t * LSP_BROW + (c16 + q * 8) * 2);
                    u32x4 o;
#pragma unroll
                    for (int i = 0; i < 4; ++i) o[i] = pk2(h2f((unsigned short)(hv[i] & 0xffffu)) * __uint_as_float(gv[i] << 16), h2f((unsigned short)(hv[i] >> 16)) * __uint_as_float(gv[i] & 0xffff0000u));
                    *(u32x4*)(so + q * 8) = o;
                }
            }
        }
    }
}

__device__ __forceinline__ void s5_load_u(const Frame& F, int g, int panel, bf16x8 (&ufa)[2][4]) {
    const int lane = F.lane, fr = lane & 15, fq = lane >> 4;
    const int row0 = panel < 64 ? panel * 256 : NTOK, nsub = panel < 64 ? 32 : 2;
    const bf16_t* us5 = WSP(bf16_t, T_US5);
#pragma unroll
    for (int nt = 0; nt < 2; ++nt)
#pragma unroll
        for (int ks = 0; ks < 4; ++ks) {
            const int sub = nt * 16 + fr;
            const int tok = row0 + sub * 8 + 2 * ks + (fq >> 1);
            ufa[nt][ks] = (panel >= 0 && sub < nsub) ? *(const bf16x8*)(us5 + ((size_t)g * MP + tok) * 16 + (fq & 1) * 8) : (bf16x8){0, 0, 0, 0, 0, 0, 0, 0};
        }
}
__device__ __forceinline__ void s5_wave_sp(const Frame& F, int layer, int g, int panel, const bf16x8 (&ufa)[2][4]) {
    const int lane = F.lane, fr = lane & 15, fq = lane >> 4;
    const int row0 = panel < 64 ? panel * 256 : NTOK, nsub = panel < 64 ? 32 : 2;
    LAS unsigned char* tb = F.lds;
    LAS unsigned char* sc = F.lds + S5_SC_OFF + F.wave * S5_SC_BYTES;
    const bf16_t* us5 = WSP(bf16_t, T_US5);
    f32x2* span = WSP(f32x2, WS_SPAN);
    unsigned* sflag = (unsigned*)(GAS unsigned*)(F.ws + WS_SFLAG);
    const unsigned epoch = (unsigned)layer + 1u;
    const f32x2 w8 = WSP(f32x2, WS_W8)[((size_t)layer * NG + g) * 64 + lane];
    float slr[32], sli[32];
    float sr = 0.f, si = 0.f;
#pragma unroll
    for (int nt = 0; nt < 2; ++nt) {
        if (nt * 16 < nsub) {
#pragma unroll
            for (int mt = 0; mt < 8; ++mt) {
                f32x4 xa = zero4();
#pragma unroll
                for (int ks = 0; ks < 4; ++ks) {
                    const bf16x8 a = *(const LAS bf16x8*)(tb + (mt * 16 + fr) * S5_TROW + (ks * 32 + fq * 8) * 2);
                    xa = __builtin_amdgcn_mfma_f32_16x16x32_bf16(a, ufa[nt][ks], xa, 0, 0, 0);
                }
                u32x2 o; o[0] = pk2(xa[0], xa[1]); o[1] = pk2(xa[2], xa[3]);
                *(LAS u32x2*)(sc + fr * S5_TROW + (mt * 16 + 4 * fq) * 2) = o;
            }
            asm volatile("s_waitcnt lgkmcnt(0)" ::: "memory");
#pragma unroll
            for (int j = 0; j < 16; ++j) {
                const LAS bf16_t* rowp = (const LAS bf16_t*)(sc + j * S5_TROW);
                const float xr = bf2f(rowp[lane]), xi = bf2f(rowp[64 + lane]);
                slr[nt * 16 + j] = sr; sli[nt * 16 + j] = si;
                if (nt * 16 + j < nsub) {
                    const float nr = w8[0] * sr - w8[1] * si + xr;
                    const float ni = w8[0] * si + w8[1] * sr + xi;
                    sr = nr; si = ni;
                }
            }
            asm volatile("s_waitcnt lgkmcnt(0)" ::: "memory");
        } else {
#pragma unroll
            for (int j = 0; j < 16; ++j) { slr[nt * 16 + j] = 0.f; sli[nt * 16 + j] = 0.f; }
        }
    }
    lb_publish64((unsigned long long*)(span + ((size_t)panel * NG + g) * 64), pack2(sr, si), sflag + (size_t)(panel * NG + g) * 16, epoch, lane);
    const float* dsk = F.in[12] + (size_t)layer * S5W + g * 16 + 4 * fq;
    const f32x4 dv = *(const f32x4*)dsk;
    u32x2 uraw0[8];
#pragma unroll
    for (int mt = 0; mt < 8; ++mt) uraw0[mt] = (fr < nsub) ? *(const u32x2*)(us5 + ((size_t)g * MP + (row0 + fr * 8 + mt)) * 16 + 4 * fq) : (u32x2){0u, 0u};
    float cr = 0.f, ci = 0.f;
    if (panel < 64) {
        const int b0 = (panel >> 5) << 5, q = (lane < 32) ? b0 + lane : 64;
        const bool need = (lane < 32) ? (q < panel) : (lane == 32);
        lb_wait(sflag + (size_t)(q * NG + g) * 16, need, epoch);
        const f32x2 w256 = WSP(f32x2, WS_W256)[((size_t)layer * NG + g) * 64 + lane];
        const f32x2 sm = lb_load2(span + ((size_t)64 * NG + g) * 64 + lane);
        cr = sm[0]; ci = sm[1];
        for (int qb = b0; qb < panel; qb += 8) {
            f32x2 x[8];
#pragma unroll
            for (int i = 0; i < 8; ++i) x[i] = (f32x2){0.f, 0.f};
            {
                const f32x2* pp[8];
#pragma unroll
                for (int i = 0; i < 8; ++i) { const int q2 = (qb + i < panel) ? qb + i : panel - 1; pp[i] = span + ((size_t)q2 * NG + g) * 64 + lane; }
                lb_load2x8(pp[0], pp[1], pp[2], pp[3], pp[4], pp[5], pp[6], pp[7], x);
            }
#pragma unroll
            for (int i = 0; i < 8; ++i) {
                if (qb + i < panel) {
                    const float nr = w256[0] * cr - w256[1] * ci + x[i][0];
                    const float ni = w256[0] * ci + w256[1] * cr + x[i][1];
                    cr = nr; ci = ni;
                }
            }
        }
    }
    bf16_t* ys5 = WSP(bf16_t, T_YS5);
    float pr = 1.f, pi = 0.f;
#pragma unroll
    for (int nt = 0; nt < 2; ++nt) {
        if (nt * 16 < nsub) {
            const int sub = nt * 16 + fr; const bool valid = sub < nsub;
#pragma unroll
            for (int j = 0; j < 16; ++j) {
                LAS bf16_t* rowp = (LAS bf16_t*)(sc + j * S5_TROW);
                rowp[lane] = f2bf(slr[nt * 16 + j] + pr * cr - pi * ci);
                rowp[64 + lane] = f2bf(sli[nt * 16 + j] + pr * ci + pi * cr);
                const float nr = pr * w8[0] - pi * w8[1], ni = pr * w8[1] + pi * w8[0];
                pr = nr; pi = ni;
            }
            asm volatile("s_waitcnt lgkmcnt(0)" ::: "memory");
            bf16x8 sf[4];
#pragma unroll
            for (int ks = 0; ks < 4; ++ks) sf[ks] = *(const LAS bf16x8*)(sc + fr * S5_TROW + (ks * 32 + fq * 8) * 2);
            u32x2 uraw[8];
#pragma unroll
            for (int mt = 0; mt < 8; ++mt) uraw[mt] = (nt == 0) ? uraw0[mt] : (valid ? *(const u32x2*)(us5 + ((size_t)g * MP + (row0 + sub * 8 + mt)) * 16 + 4 * fq) : (u32x2){0u, 0u});
#pragma unroll
            for (int mt = 0; mt < 8; ++mt) {
                f32x4 ya = zero4();
#pragma unroll
                for (int ks = 0; ks < 4; ++ks) {
                    const bf16x8 a = *(const LAS bf16x8*)(tb + S5_TBYTES + (mt * 16 + fr) * S5_TROW + (ks * 32 + fq * 8) * 2);
                    ya = __builtin_amdgcn_mfma_f32_16x16x32_bf16(a, ufa[nt][ks], ya, 0, 0, 0);
                }
#pragma unroll
                for (int ks = 0; ks < 4; ++ks) {
                    const bf16x8 a = *(const LAS bf16x8*)(tb + 2 * S5_TBYTES + (mt * 16 + fr) * S5_TROW + (ks * 32 + fq * 8) * 2);
                    ya = __builtin_amdgcn_mfma_f32_16x16x32_bf16(a, sf[ks], ya, 0, 0, 0);
                }
                if (valid) {
                    const int tok = row0 + sub * 8 + mt, ch = g * 16 + 4 * fq;
                    const f32x4 u = unpk4(__uint_as_float(uraw[mt][0]), __uint_as_float(uraw[mt][1]));
                    f32x4 o; o[0] = gelu_tanh(ya[0] + dv[0] * u[0]); o[1] = gelu_tanh(ya[1] + dv[1] * u[1]); o[2] = gelu_tanh(ya[2] + dv[2] * u[2]); o[3] = gelu_tanh(ya[3] + dv[3] * u[3]);
                    st4bf(ys5 + (size_t)tok * 512 + ch, o);
                }
            }
            asm volatile("s_waitcnt lgkmcnt(0)" ::: "memory");
        }
    }
}
__device__ __forceinline__ void s5_phase_sp(const Frame& G, int layer, int first, int stride, bool fold_meta = false) {
    const Frame F = local_frame(G);
    for (int wu = first; wu < NG * 9; wu += stride) {
        const int g = wu % NG, oct = wu / NG - 1;
        const bool with_meta = fold_meta && oct == 0 && F.wave == 0;
        const int panel = oct >= 0 ? oct * 8 + F.wave : (F.wave == 0 ? 64 : -1);
        bf16x8 ufa[2][4];
        s5_load_u(F, g, with_meta ? 64 : panel, ufa);
        __syncthreads();
        const bf16_t* T = WSP(bf16_t, WS_S5T) + ((size_t)layer * NG + g) * 3 * 16384;
        for (int i = F.tid; i < 3 * 128 * 16; i += NTHREADS) {
            const int tbl = i >> 11, r = (i >> 4) & 127, c = i & 15;
            *(LAS u32x4*)(F.lds + tbl * S5_TBYTES + r * S5_TROW + c * 16) = *(const u32x4*)(T + (size_t)tbl * 16384 + r * 128 + c * 8);
        }
        __syncthreads();
        for (int rep_ = 0; rep_ < (with_meta ? 2 : 1); ++rep_) {
            const int pnow = (with_meta && rep_ == 0) ? 64 : panel;
            if (rep_ == 1) s5_load_u(F, g, panel, ufa);
            if (pnow >= 0) s5_wave_sp(F, layer, g, pnow, ufa);
        }
    }
}

__device__ __forceinline__ void moe_router(const Frame& G, int layer, int c_lo, int c_hi) {
    const Frame F = local_frame(G);
    const int j = layer >> 1;
    LAS float* gw = (LAS float*)F.lds;
    LAS int* esel = (LAS int*)(gw + 8 * 1028);
    const float* fn = F.in[25] + (size_t)layer * D; const float* rw = F.in[29] + (size_t)j * D * 8; const float* rb = F.in[30] + j * 8;
    __syncthreads();
    for (int i = F.tid; i < 8192; i += NTHREADS) gw[(i & 7) * 1028 + (i >> 3)] = fn[i >> 3] * rw[i];
    const float* hs = WSP(float, WS_HS);
    int* tope = WSP(int, WS_TOPE); float* topg = WSP(float, WS_TOPG); float* rinv = WSP(float, WS_RINV); int* cnt = WSP(int, WS_CNT);
    for (int chunk = (c_lo < 0 ? F.blk : c_lo); chunk < c_hi; chunk += (c_lo < 0 ? F.nblk : 1)) {
        __syncthreads();
        for (int ps = 0; ps < 2; ++ps) {
            const int rl = F.wave * 8 + ps * 4 + (F.lane >> 4), row = chunk * 64 + rl, l16 = F.lane & 15;
            const bool rv = row < NV;
            float ss = 0.f, lg[8];
#pragma unroll
            for (int e = 0; e < 8; ++e) lg[e] = 0.f;
            f32x4 hv[16];
#pragma unroll
            for (int i = 0; i < 16; ++i) hv[i] = rv ? __builtin_nontemporal_load((const f32x4*)(hs + (size_t)row * D + i * 64 + l16 * 4)) : zero4();
#pragma unroll
            for (int i = 0; i < 16; ++i) {
                const int k = i * 64 + l16 * 4;
                const f32x4 v = hv[i];
                ss += v[0] * v[0] + v[1] * v[1] + v[2] * v[2] + v[3] * v[3];
#pragma unroll
                for (int e = 0; e < 8; ++e) {
                    const f32x4 w = *(const LAS f32x4*)(gw + e * 1028 + k);
                    lg[e] += v[0] * w[0] + v[1] * w[1] + v[2] * w[2] + v[3] * w[3];
                }
            }
#pragma unroll
            for (int o = 8; o >= 1; o >>= 1) {
                ss += shflx(ss, F.lane, o);
#pragma unroll
                for (int e = 0; e < 8; ++e) lg[e] += shflx(lg[e], F.lane, o);
            }
            if (rv) {
                const float ri = rsqrtf(ss * (1.0f / D) + EPS);
                int e0 = 0; float l0 = -3.0e38f;
#pragma unroll
                for (int e = 0; e < 8; ++e) { lg[e] = lg[e] * ri + rb[e]; if (lg[e] > l0) { l0 = lg[e]; e0 = e; } }
                int e1 = 0; float l1 = -3.0e38f;
#pragma unroll
                for (int e = 0; e < 8; ++e) { if (e != e0 && lg[e] > l1) { l1 = lg[e]; e1 = e; } }
                const float g0 = 1.0f / (1.0f + __expf(l1 - l0)), g1 = 1.0f - g0;
                if (l16 == 0) { tope[row * 2] = e0; tope[row * 2 + 1] = e1; topg[row * 2] = g0; topg[row * 2 + 1] = g1; rinv[row] = ri; esel[rl * 2] = e0; esel[rl * 2 + 1] = e1; }
            } else if (l16 == 0) { int m1 = -1; OPAQUE(m1); esel[rl * 2] = m1; esel[rl * 2 + 1] = m1; }
        }
        __syncthreads();
        if (F.tid < 8) { int n = 0; for (int i = 0; i < 128; ++i) n += (esel[i] == F.tid) ? 1 : 0; cnt[chunk * 8 + F.tid] = n; }
    }
}
__device__ __forceinline__ void moe_dispatch(const Frame& G) {
    const Frame F = local_frame(G);
    LAS int* pre = (LAS int*)F.lds;
    LAS int* tot = pre + NCHUNK * 8;
    const int* cnt = WSP(int, WS_CNT);
    const int* tope = WSP(int, WS_TOPE); const float* topg = WSP(float, WS_TOPG);
    int* stok = WSP(int, WS_STOK); float* sgate = WSP(float, WS_SGATE); int* tslot = WSP(int, WS_TSLOT); int* texp = WSP(int, WS_TEXP);
    __syncthreads();
    {
        const int e = F.wave, l = F.lane;
        const int v0 = cnt[(4 * l + 0) * 8 + e], v1 = cnt[(4 * l + 1) * 8 + e], v2 = cnt[(4 * l + 2) * 8 + e], v3 = cnt[(4 * l + 3) * 8 + e];
        const int v4 = (l == 63) ? cnt[256 * 8 + e] : 0;
        const int local = v0 + v1 + v2 + v3 + v4;
        int inc = local;
#pragma unroll
        for (int o = 1; o < 64; o <<= 1) { const int t = shfl_up_i(inc, l, o); if (l >= o) inc += t; }
        const int exc = inc - local;
        pre[(4 * l + 0) * 8 + e] = exc; pre[(4 * l + 1) * 8 + e] = exc + v0; pre[(4 * l + 2) * 8 + e] = exc + v0 + v1; pre[(4 * l + 3) * 8 + e] = exc + v0 + v1 + v2;
        if (l == 63) { pre[256 * 8 + e] = exc + v0 + v1 + v2 + v3; tot[e] = inc; }
    }
    __syncthreads();
    if (F.tid == 0) { int st = 0; for (int e = 0; e < 8; ++e) { tot[8 + e] = st; st += ((tot[e] + 255) >> 8) << 8; } tot[16] = st >> 8; }
    __syncthreads();
    if (F.blk == 0) {
        const int ntile = tot[16];
        for (int t = F.tid; t < ntile; t += NTHREADS) { int e = 0; for (int x = 1; x < 8; ++x) if (t * 256 >= tot[8 + x]) e = x; texp[t] = e; }
        if (F.tid == 0) texp[200] = ntile;
        for (int e = 0; e < 8; ++e) {
            const int lo = tot[8 + e] + tot[e], hi = tot[8 + e] + (((tot[e] + 255) >> 8) << 8);
            for (int s = lo + F.tid; s < hi; s += NTHREADS) { stok[s] = 0; sgate[s] = 0.f; WSP(float, WS_SA)[s] = 0.f; }
        }
    }
    LAS int* sl = tot + 32;
    const float* hs = WSP(float, WS_HS); const float* rinv = WSP(float, WS_RINV); unsigned char* xs = WSP(unsigned char, F_XS);
    if (F.blk == 0) {
        for (int e = 0; e < 8; ++e) {
            const int lo = tot[8 + e] + tot[e], hi = tot[8 + e] + (((tot[e] + 255) >> 8) << 8);
            for (int s = lo + F.wave; s < hi; s += 8)
                { unsigned zz = 0u; OPAQUE(zz); u32x4 z; z[0] = zz; z[1] = zz; z[2] = zz; z[3] = zz; *(u32x4*)(xs + ((size_t)s * D + F.lane * 16) * UESZ) = z; if (UESZ == 2) *(u32x4*)(xs + ((size_t)s * D + F.lane * 16) * UESZ + 16) = z; }
        }
    }
    for (int chunk = F.blk; chunk < NCHUNK; chunk += F.nblk) {
        __syncthreads();
        if (F.wave == 0) {
            const int row = chunk * 64 + F.lane; const bool valid = row < NV;
            const int e0 = valid ? tope[row * 2] : -1, e1 = valid ? tope[row * 2 + 1] : -1;
            const unsigned long long lt = (1ull << F.lane) - 1ull;
            int r0 = 0, r1 = 0;
#pragma unroll
            for (int x = 0; x < 8; ++x) {
                const unsigned long long m0 = __ballot(e0 == x), m1 = __ballot(e1 == x);
                const int before = __popcll(m0 & lt) + __popcll(m1 & lt);
                if (e0 == x) r0 = before;
                if (e1 == x) r1 = before;
            }
            int s0 = -1, s1 = -1;
            if (valid) {
                s0 = tot[8 + e0] + pre[chunk * 8 + e0] + r0; s1 = tot[8 + e1] + pre[chunk * 8 + e1] + r1;
                stok[s0] = row; sgate[s0] = topg[row * 2]; stok[s1] = row; sgate[s1] = topg[row * 2 + 1];
                tslot[row * 2] = s0; tslot[row * 2 + 1] = s1;
            }
            sl[F.lane * 2] = s0; sl[F.lane * 2 + 1] = s1;
        }
        __syncthreads();
        if constexpr (UMM == 3) {
            for (int ps = 0; ps < 2; ++ps) {
                const int rl = F.wave * 8 + ps * 4 + (F.lane >> 4), row = chunk * 64 + rl, l16 = F.lane & 15;
                const int s0 = sl[rl * 2], s1 = sl[rl * 2 + 1];
                const bool rv = s0 >= 0;
                f32x4 v[16]; float mx = 0.f;
#pragma unroll
                for (int i = 0; i < 16; ++i) v[i] = rv ? *(const f32x4*)(hs + (size_t)row * D + l16 * 64 + i * 4) : zero4();
#pragma unroll
                for (int i = 0; i < 16; ++i) mx = fmaxf(fmaxf(mx, fmaxf(fabsf(v[i][0]), fabsf(v[i][1]))), fmaxf(fabsf(v[i][2]), fabsf(v[i][3])));
#pragma unroll
                for (int o2 = 8; o2 >= 1; o2 >>= 1) mx = fmaxf(mx, shflx(mx, F.lane, o2));
                if (rv) {
                    const float qs = mx > 0.f ? 127.0f / mx : 0.f;
#pragma unroll
                    for (int q = 0; q < 4; ++q) {
                        u32x4 o;
#pragma unroll
                        for (int i = 0; i < 4; ++i) { const f32x4 w = v[q * 4 + i]; const int q0 = (int)rintf(w[0] * qs), q1 = (int)rintf(w[1] * qs), q2 = (int)rintf(w[2] * qs), q3 = (int)rintf(w[3] * qs);
                            o[i] = (unsigned)(q0 & 255) | ((unsigned)(q1 & 255) << 8) | ((unsigned)(q2 & 255) << 16) | ((unsigned)(q3 & 255) << 24); }
                        *(u32x4*)(xs + (size_t)s0 * D + l16 * 64 + q * 16) = o; *(u32x4*)(xs + (size_t)s1 * D + l16 * 64 + q * 16) = o;
                    }
                    if (l16 == 0) { const float sc = mx * rinv[row] * (1.0f / 127.0f); WSP(float, WS_SA)[s0] = sc; WSP(float, WS_SA)[s1] = sc; }
                }
            }
        } else
        for (int rr = 0; rr < 8; ++rr) {
            const int rl = F.wave * 8 + rr, row = chunk * 64 + rl;
            const int s0 = sl[rl * 2], s1 = sl[rl * 2 + 1];
            if (s0 >= 0) {
                const float ri = rinv[row];
                if constexpr (UMM == 3) {
                    f32x4 v[4]; float mx = 0.f;
#pragma unroll
                    for (int i = 0; i < 4; ++i) { v[i] = *(const f32x4*)(hs + (size_t)row * D + F.lane * 16 + i * 4); mx = fmaxf(fmaxf(mx, fmaxf(fabsf(v[i][0]), fabsf(v[i][1]))), fmaxf(fabsf(v[i][2]), fabsf(v[i][3]))); }
#pragma unroll
                    for (int o2 = 32; o2 >= 1; o2 >>= 1) mx = fmaxf(mx, shflx(mx, F.lane, o2));
                    const float qs = mx > 0.f ? 127.0f / mx : 0.f;
                    u32x4 o;
#pragma unroll
                    for (int i = 0; i < 4; ++i) { const int q0 = (int)rintf(v[i][0] * qs), q1 = (int)rintf(v[i][1] * qs), q2 = (int)rintf(v[i][2] * qs), q3 = (int)rintf(v[i][3] * qs);
                        o[i] = (unsigned)(q0 & 255) | ((unsigned)(q1 & 255) << 8) | ((unsigned)(q2 & 255) << 16) | ((unsigned)(q3 & 255) << 24); }
                    *(u32x4*)(xs + (size_t)s0 * D + F.lane * 16) = o; *(u32x4*)(xs + (size_t)s1 * D + F.lane * 16) = o;
                    if (F.lane == 0) { const float sc = mx * ri * (1.0f / 127.0f); WSP(float, WS_SA)[s0] = sc; WSP(float, WS_SA)[s1] = sc; }
                } else if constexpr (UESZ == 1) {
                    u32x4 o;
#pragma unroll
                    for (int i = 0; i < 4; ++i) { const f32x4 v = *(const f32x4*)(hs + (size_t)row * D + F.lane * 16 + i * 4) * ri; o[i] = pk4f8(v[0], v[1], v[2], v[3]); }
                    *(u32x4*)(xs + (size_t)s0 * D + F.lane * 16) = o; *(u32x4*)(xs + (size_t)s1 * D + F.lane * 16) = o;
                } else {
                    u32x4 o0, o1;
#pragma unroll
                    for (int i = 0; i < 2; ++i) { const f32x4 v = *(const f32x4*)(hs + (size_t)row * D + F.lane * 16 + i * 4) * ri, w = *(const f32x4*)(hs + (size_t)row * D + F.lane * 16 + 8 + i * 4) * ri;
                        o0[2 * i] = pk2(v[0], v[1]); o0[2 * i + 1] = pk2(v[2], v[3]); o1[2 * i] = pk2(w[0], w[1]); o1[2 * i + 1] = pk2(w[2], w[3]); }
                    bf16_t* x0 = (bf16_t*)xs + (size_t)s0 * D + F.lane * 16; bf16_t* x1 = (bf16_t*)xs + (size_t)s1 * D + F.lane * 16;
                    *(u32x4*)x0 = o0; *(u32x4*)(x0 + 8) = o1; *(u32x4*)x1 = o0; *(u32x4*)(x1 + 8) = o1;
                }
            }
        }
    }
}
__device__ __forceinline__ void moe_route_dispatch(const Frame& G, int layer) {
    const Frame F = local_frame(G);
    const int j = layer >> 1;
    const bool dead_meta = SKIP_DEAD_META && layer == DEPTH - 1;
    constexpr int RSTR = 1040;
    LAS float* gw = (LAS float*)F.lds;
    LAS int* esel = (LAS int*)(gw + 8 * 1028);
    LAS float* eg = (LAS float*)(esel + 160);
    LAS float* esc = eg + 160;
    LAS int* sl = (LAS int*)(esc + 80);
    LAS unsigned char* rows = F.lds + 36864;
    const float* fn = F.in[25] + (size_t)layer * D; const float* rw = F.in[29] + (size_t)j * D * 8; const float* rb = F.in[30] + j * 8;
    unsigned* cntx = (unsigned*)(GAS unsigned*)(F.ws + WS_CNTX);
    const unsigned epoch = (unsigned)(layer + 1);
    const float* hs = WSP(float, WS_HS);
    __syncthreads();
    for (int i = F.tid; i < 8192; i += NTHREADS) gw[(i & 7) * 1028 + (i >> 3)] = fn[i >> 3] * rw[i];
    for (int ci = 0; ci < 2; ++ci) {
        const int chunk = F.blk + ci * F.nblk;
        if (chunk >= NCHUNK) break;
        __syncthreads();
        for (int ps = 0; ps < 2; ++ps) {
            const int rl = F.wave * 8 + ps * 4 + (F.lane >> 4), row = chunk * 64 + rl, l16 = F.lane & 15;
            const bool rv = row < NV && !(dead_meta && ci == 1);
            if (ci == 1 && rl >= 16) continue;
            float ss = 0.f, mx = 0.f, lg[8];
#pragma unroll
            for (int e = 0; e < 8; ++e) lg[e] = 0.f;
            f32x4 hv[16];
#pragma unroll
            for (int i = 0; i < 16; ++i) hv[i] = rv ? __builtin_nontemporal_load((const f32x4*)(hs + (size_t)row * D + i * 64 + l16 * 4)) : zero4();
#pragma unroll
            for (int i = 0; i < 16; ++i) {
                const int k = i * 64 + l16 * 4;
                const f32x4 v = hv[i];
                ss += v[0] * v[0] + v[1] * v[1] + v[2] * v[2] + v[3] * v[3];
                mx = fmaxf(fmaxf(mx, fmaxf(fabsf(v[0]), fabsf(v[1]))), fmaxf(fabsf(v[2]), fabsf(v[3])));
#pragma unroll
                for (int e = 0; e < 8; ++e) {
                    const f32x4 w = *(const LAS f32x4*)(gw + e * 1028 + k);
                    lg[e] += v[0] * w[0] + v[1] * w[1] + v[2] * w[2] + v[3] * w[3];
                }
            }
#pragma unroll
            for (int o = 8; o >= 1; o >>= 1) {
                ss += shflx(ss, F.lane, o); mx = fmaxf(mx, shflx(mx, F.lane, o));
#pragma unroll
                for (int e = 0; e < 8; ++e) lg[e] += shflx(lg[e], F.lane, o);
            }
            const int lrow = ci * 64 + rl;
            if (rv) {
                const float ri = rsqrtf(ss * (1.0f / D) + EPS);
                int e0 = 0; float l0 = -3.0e38f;
#pragma unroll
                for (int e = 0; e < 8; ++e) { lg[e] = lg[e] * ri + rb[e]; if (lg[e] > l0) { l0 = lg[e]; e0 = e; } }
                int e1 = 0; float l1 = -3.0e38f;
#pragma unroll
                for (int e = 0; e < 8; ++e) { if (e != e0 && lg[e] > l1) { l1 = lg[e]; e1 = e; } }
                const float g0 = 1.0f / (1.0f + __expf(l1 - l0)), g1 = 1.0f - g0;
                if (l16 == 0) { esel[lrow * 2] = e0; esel[lrow * 2 + 1] = e1; eg[lrow * 2] = g0; eg[lrow * 2 + 1] = g1; esc[lrow] = mx * ri * (1.0f / 127.0f); }
                const float qs = mx > 0.f ? 127.0f / mx : 0.f;
#pragma unroll
                for (int i = 0; i < 16; ++i) {
                    const f32x4 w = hv[i];
                    const int q0 = (int)rintf(w[0] * qs), q1 = (int)rintf(w[1] * qs), q2 = (int)rintf(w[2] * qs), q3 = (int)rintf(w[3] * qs);
                    *(LAS unsigned*)(rows + lrow * RSTR + i * 64 + l16 * 4) = (unsigned)(q0 & 255) | ((unsigned)(q1 & 255) << 8) | ((unsigned)(q2 & 255) << 16) | ((unsigned)(q3 & 255) << 24);
                }
            } else if (l16 == 0) { int m1 = -1; OPAQUE(m1); esel[lrow * 2] = m1; esel[lrow * 2 + 1] = m1; }
        }
        __syncthreads();
        if (F.tid < 8) {
            const int nrow = ci ? 16 : 64; int n = 0;
            for (int i = 0; i < nrow * 2; ++i) n += (esel[ci * 128 + i] == F.tid) ? 1 : 0;
            __hip_atomic_store(cntx + chunk * 8 + F.tid, (epoch << 16) | (unsigned)n, RLX_AGENT);
        }
    }
    __syncthreads();
    LAS int* pre = (LAS int*)F.lds;
    LAS int* tot = pre + NCHUNK * 8;
    {
        const int e = F.wave, l = F.lane;
        unsigned w0, w1, w2, w3, w4; unsigned sp = 0;
        for (;;) {
            w0 = __hip_atomic_load(cntx + (4 * l + 0) * 8 + e, RLX_AGENT); w1 = __hip_atomic_load(cntx + (4 * l + 1) * 8 + e, RLX_AGENT);
            w2 = __hip_atomic_load(cntx + (4 * l + 2) * 8 + e, RLX_AGENT); w3 = __hip_atomic_load(cntx + (4 * l + 3) * 8 + e, RLX_AGENT);
            w4 = (l == 63) ? __hip_atomic_load(cntx + 256 * 8 + e, RLX_AGENT) : (epoch << 16);
            const bool ok = ((w0 >> 16) == epoch) && ((w1 >> 16) == epoch) && ((w2 >> 16) == epoch) && ((w3 >> 16) == epoch) && ((w4 >> 16) == epoch);
            if (__all(ok)) break;
            __builtin_amdgcn_s_sleep(2);
            if (++sp > (1u << 22)) break;
        }
        const int v0 = (int)(w0 & 0xffffu), v1 = (int)(w1 & 0xffffu), v2 = (int)(w2 & 0xffffu), v3 = (int)(w3 & 0xffffu), v4 = (int)(w4 & 0xffffu);
        const int local = v0 + v1 + v2 + v3 + v4;
        int inc = local;
#pragma unroll
        for (int o = 1; o < 64; o <<= 1) { const int t = shfl_up_i(inc, l, o); if (l >= o) inc += t; }
        const int exc = inc - local;
        pre[(4 * l + 0) * 8 + e] = exc; pre[(4 * l + 1) * 8 + e] = exc + v0; pre[(4 * l + 2) * 8 + e] = exc + v0 + v1; pre[(4 * l + 3) * 8 + e] = exc + v0 + v1 + v2;
        if (l == 63) { pre[256 * 8 + e] = exc + v0 + v1 + v2 + v3; tot[e] = inc; }
    }
    __syncthreads();
    if (F.tid == 0) { int st = 0; for (int e = 0; e < 8; ++e) { tot[8 + e] = st; st += ((tot[e] + 255) >> 8) << 8; } tot[16] = st >> 8; }
    __syncthreads();
    int* stok = WSP(int, WS_STOK); float* sgate = WSP(float, WS_SGATE); int* tslot = WSP(int, WS_TSLOT); int* texp = WSP(int, WS_TEXP);
    unsigned char* xs = WSP(unsigned char, F_XS);
    if (F.blk == 0) {
        const int ntile = tot[16];
        for (int t = F.tid; t < ntile; t += NTHREADS) { int e = 0; for (int x = 1; x < 8; ++x) if (t * 256 >= tot[8 + x]) e = x; texp[t] = e; }
        if (F.tid == 0) texp[200] = ntile;
        for (int e = 0; e < 8; ++e) {
            const int lo = tot[8 + e] + tot[e], hi = tot[8 + e] + (((tot[e] + 255) >> 8) << 8);
            for (int s = lo + F.tid; s < hi; s += NTHREADS) { stok[s] = 0; sgate[s] = 0.f; WSP(float, WS_SA)[s] = 0.f; }
            for (int s = lo + F.wave; s < hi; s += 8) { unsigned zz = 0u; OPAQUE(zz); u32x4 z; z[0] = zz; z[1] = zz; z[2] = zz; z[3] = zz; *(u32x4*)(xs + (size_t)s * D + F.lane * 16) = z; }
        }
    }
    for (int ci = 0; ci < 2; ++ci) {
        const int chunk = F.blk + ci * F.nblk;
        if (chunk >= NCHUNK) break;
        __syncthreads();
        if (F.wave == 0) {
            const int row = chunk * 64 + F.lane; const bool valid = row < NV && !(dead_meta && ci == 1);
            const int e0 = valid ? esel[(ci * 64 + F.lane) * 2] : -1, e1 = valid ? esel[(ci * 64 + F.lane) * 2 + 1] : -1;
            const unsigned long long lt = (1ull << F.lane) - 1ull;
            int r0 = 0, r1 = 0;
#pragma unroll
            for (int x = 0; x < 8; ++x) {
                const unsigned long long m0 = __ballot(e0 == x), m1 = __ballot(e1 == x);
                const int before = __popcll(m0 & lt) + __popcll(m1 & lt);
                if (e0 == x) r0 = before;
                if (e1 == x) r1 = before;
            }
            int s0 = -1, s1 = -1;
            if (valid) {
                s0 = tot[8 + e0] + pre[chunk * 8 + e0] + r0; s1 = tot[8 + e1] + pre[chunk * 8 + e1] + r1;
                stok[s0] = row; sgate[s0] = eg[(ci * 64 + F.lane) * 2]; stok[s1] = row; sgate[s1] = eg[(ci * 64 + F.lane) * 2 + 1];
                tslot[row * 2] = s0; tslot[row * 2 + 1] = s1;
            }
            if (ci == 0 || F.lane < 16) { sl[(ci * 64 + F.lane) * 2] = s0; sl[(ci * 64 + F.lane) * 2 + 1] = s1; }
        }
        __syncthreads();
        for (int rr = 0; rr < 8; ++rr) {
            const int rl = F.wave * 8 + rr;
            if (ci == 1 && rl >= 16) break;
            const int lrow = ci * 64 + rl;
            const int s0 = sl[lrow * 2], s1 = sl[lrow * 2 + 1];
            if (s0 >= 0) {
                const u32x4 o = *(const LAS u32x4*)(rows + lrow * RSTR + F.lane * 16);
                *(u32x4*)(xs + (size_t)s0 * D + F.lane * 16) = o; *(u32x4*)(xs + (size_t)s1 * D + F.lane * 16) = o;
                if (F.lane == 0) { const float sc = esc[lrow]; WSP(float, WS_SA)[s0] = sc; WSP(float, WS_SA)[s1] = sc; }
            }
        }
    }
}
__device__ __forceinline__ void moe_combine(const Frame& G, int layer, int dry) {
    const Frame F = local_frame(G);
    float* hs = WSP(float, WS_HS); bf16_t* hsb = WSP(bf16_t, WS_HSB); float* rsp = WSP(float, WS_RSP);
    const bf16_t* ys = WSP(bf16_t, F_YS); const int* tslot = WSP(int, WS_TSLOT);
    const float* fn = F.in[34];
    f32x4 fng[4];
#pragma unroll
    for (int i = 0; i < 4; ++i) fng[i] = (layer == DEPTH - 1) ? *(const f32x4*)(fn + i * 256 + F.lane * 4) : zero4();
    const int nrows = (SKIP_DEAD_META && layer == DEPTH - 1) ? NTOK : NV;
    for (int row0 = F.blk * 8 + F.wave; row0 < nrows; row0 += F.nblk * 16) {
        const int row1 = row0 + F.nblk * 8; const bool has1 = row1 < nrows;
        const int r1 = has1 ? row1 : row0;
        const int s00 = tslot[row0 * 2], s01 = tslot[row0 * 2 + 1], s10 = tslot[r1 * 2], s11 = tslot[r1 * 2 + 1];
        f32x4 h0[4], h1[4]; u32x2 a0[4], b0[4], a1[4], b1[4];
#pragma unroll
        for (int i = 0; i < 4; ++i) {
            const int k = i * 256 + F.lane * 4;
            h0[i] = __builtin_nontemporal_load((const f32x4*)(hs + (size_t)row0 * D + k)); a0[i] = __builtin_nontemporal_load((const u32x2*)(ys + (size_t)s00 * D + k)); b0[i] = __builtin_nontemporal_load((const u32x2*)(ys + (size_t)s01 * D + k));
            h1[i] = __builtin_nontemporal_load((const f32x4*)(hs + (size_t)r1 * D + k)); a1[i] = __builtin_nontemporal_load((const u32x2*)(ys + (size_t)s10 * D + k)); b1[i] = __builtin_nontemporal_load((const u32x2*)(ys + (size_t)s11 * D + k));
        }
#pragma unroll
        for (int rr = 0; rr < 2; ++rr) {
            if (rr == 1 && !has1) break;
            const int row = rr ? row1 : row0;
            f32x4 v[4]; float ss = 0.f;
#pragma unroll
            for (int i = 0; i < 4; ++i) {
                const int k = i * 256 + F.lane * 4;
                const u32x2 pa = rr ? a1[i] : a0[i], pb = rr ? b1[i] : b0[i];
                const f32x4 h = rr ? h1[i] : h0[i];
                const f32x4 a = unpk4(__uint_as_float(pa[0]), __uint_as_float(pa[1])), b = unpk4(__uint_as_float(pb[0]), __uint_as_float(pb[1]));
                v[i] = (h + a) + b;
                if (!dry && !(SKIP_DEAD_META && layer == DEPTH - 1)) { *(f32x4*)(hs + (size_t)row * D + k) = v[i];
                if (NEED_HSB) st4bf(hsb + (size_t)row * D + k, v[i]); }
                ss += v[i][0] * v[i][0] + v[i][1] * v[i][1] + v[i][2] * v[i][2] + v[i][3] * v[i][3];
            }
#pragma unroll
            for (int o = 32; o >= 1; o >>= 1) ss += shflx(ss, F.lane, o);
            if (NEED_HSB && !dry && F.lane < 16) rsp[(size_t)row * 16 + F.lane] = (F.lane == 0) ? ss : 0.f;
            if (WMM == 3 && !dry && layer + 1 < DEPTH) quant_row_store(v, ss, F.lane, WSP(unsigned char, WS_HSB8) + (size_t)row * D, WSP(float, WS_SA) + row);
            if (dry) asm volatile("" :: "v"(ss));
            if (!dry && layer == DEPTH - 1 && row < NTOK) {
                const float ri = rsqrtf(ss * (1.0f / D) + EPS);
#pragma unroll
                for (int i = 0; i < 4; ++i) {
                    const int k = i * 256 + F.lane * 4;
                    const f32x4 g = fng[i];
                    f32x4 o; o[0] = v[i][0] * ri * g[0]; o[1] = v[i][1] * ri * g[1]; o[2] = v[i][2] * ri * g[2]; o[3] = v[i][3] * ri * g[3];
                    *(f32x4*)(F.out + (size_t)row * D + k) = o;
                }
            }
        }
    }
}

constexpr int LDS_BYTES = 147456;
constexpr int LDS_MISC = LDS_BYTES - 64;
constexpr int STEPS_PER_LAYER = 12;
constexpr int NSTEPS = 1 + DEPTH * STEPS_PER_LAYER;

__global__ void __launch_bounds__(NTHREADS, 2) fwd(Params P) {
    extern __shared__ __attribute__((aligned(16))) unsigned char lds_raw[];
    Frame F0;
    F0.lds = (LAS unsigned char*)lds_raw;
    F0.tid = threadIdx.x; F0.lane = F0.tid & 63; F0.wave = __builtin_amdgcn_readfirstlane(F0.tid >> 6);
    F0.blk = blockIdx.x; F0.nblk = gridDim.x; F0.ws = (GAS unsigned char*)P.ws; F0.in = P.in; F0.out = P.out;
#if ONE_LAUNCH
    const int lo = 0, hi = NSTEPS;
#else
    const int lo = P.s_lo, hi = P.s_hi;
#endif
#if ONE_LAUNCH
    if (F0.tid < 16) ((LAS unsigned*)(F0.lds + LDS_MISC))[F0.tid] = 0u;
    __syncthreads();
    XcdBarrier bar = xcd_barrier_post((unsigned*)(GAS unsigned*)(F0.ws + WS_CTL), (volatile LAS unsigned*)(F0.lds + LDS_MISC));
#define GRID_SYNC() xcd_barrier(bar)
#else
#define GRID_SYNC() do { } while (0)
#endif
#if defined(ONLY)
#define PHSEL(n) (ONLY == (n))
#elif defined(PHMASK)
#define PHSEL(n) (((PHMASK) >> (n)) & 1)
#else
#define PHSEL(n) 1
#endif
#define IN(k) (lo <= (k) && (k) < hi)
#define SEAM(k) do { if (IN(k) && IN((k) + 1)) GRID_SYNC(); } while (0)

    for (int rp = 0; rp <= REPS(0); ++rp) if (PHSEL(0) && IN(0)) { const Frame F = local_frame(F0); prologue(F); SEAM(0); }
    for (int layer = 0; layer < DEPTH; ++layer) {
        const int sb = 1 + layer * STEPS_PER_LAYER;
#ifdef XBAR
        for (int xb = 0; xb < XBAR; ++xb) GRID_SYNC();
#endif
        const bool moe = (layer & 1) != 0; const int j = layer >> 1;
        for (int rp = 0; rp <= REPS(1); ++rp) if (PHSEL(1) && IN(sb + 0)) { const Frame F = local_frame(F0);

            EpiWin E{WSP(float, WS_RSP), WSP(bf16_t, T_US5), WSP(bf16_t, T_XLRU), WSP(bf16_t, T_GG), WSP(bf16_t, T_GATES), F.in[4] + (size_t)layer * 2048};
            dense_gemm<EpiWin, WMM>(F, WMM == 3 ? (const void*)WSP(unsigned char, WS_HSB8) : (const void*)WSP(bf16_t, WS_HSB), WSP(unsigned char, WS_WIN + layer * SZ_WIN), DIN, D, E, WSP(float, WS_SA), WSP(float, WS_CMAX) + CMAX_WIN + layer * DIN, nullptr, WIN_SPLIT ? WIN_NB : -1, WIN_SPLIT ? 1536 / 64 : -1);
            SEAM(sb + 0);
        }
        for (int rp = 0; rp <= REPS(2); ++rp) if (PHSEL(2) && IN(sb + 1)) { const Frame F = local_frame(F0);
            constexpr int NMETA_U = 8, NFULL_U = NG * 8 + 64 * 8;
            for (int q = F.blk; q < NMETA_U + NFULL_U; q += F.nblk) {
                int wu = -1, lp = 0, lh = 0;
                if (q < NMETA_U) { lp = 64; lh = q; }
                else {
                    const int p = q - NMETA_U, t = p / 3, r = p - 3 * t;
                    if (r == 0) wu = NG + t;
                    else { const int j = 2 * t + (r - 1); lp = j >> 3; lh = j & 7; }
                }
                if (wu >= 0) s5_phase_sp(F, layer, wu, NG * 9, true);
                else if (lp == 64) lru_unit_sp(F, layer, 64, lh);
                else lru_unit_sp(F, layer, lp, lh);
            }
            SEAM(sb + 1);
        }
        for (int rp = 0; rp <= REPS(4); ++rp) if (PHSEL(4) && IN(sb + 3)) { const Frame F = local_frame(F0);
            APlain ap{WSP(bf16_t, T_YS5), 512}; BPlain bp{WSP(bf16_t, WS_WGLU + layer * SZ_WGLU)};
            EpiGlu E{WSP(bf16_t, T_YS5), F.in[14] + (size_t)layer * 512, WSP(bf16_t, T_SOLO)};
            if (!WIN_SPLIT) dense_gemm(F, ap.A, bp.Bt, 512, 512, E);
            else {
                const int nfirst = F.nblk >> 1;
                EpiWin EW{WSP(float, WS_RSP), WSP(bf16_t, T_US5), WSP(bf16_t, T_XLRU), WSP(bf16_t, T_GG), WSP(bf16_t, T_GATES), F.in[4] + (size_t)layer * 2048};
                const unsigned char* wa = WSP(unsigned char, WS_HSB8); const unsigned char* wb = WSP(unsigned char, WS_WIN + layer * SZ_WIN);
                const float* wsb = WSP(float, WS_CMAX) + CMAX_WIN + layer * DIN;
                if (F.blk < nfirst) {
                    { const Frame L = local_frame(F); pg8::DenseOrder S; S.init(ap.A, bp.Bt, NTOK, 512, 512, 2, nfirst, L.blk);
                      pg8::gemm_phase<EpiGlu, pg8::DenseOrder, 2>(L.lds, 512, 512, 512, S, E, L.tid); }
                    for (int v = F.blk; v < ((SKIP_DEAD_META && layer == DEPTH - 1) ? 0 : 8 + (DIN - 1536) / 64); v += nfirst) {
                        const Frame R = local_frame(F);
                        if (v < 8) rider_gemm<EpiGlu, false, 2>(R, ap.A, 512, bp.Bt, 512, 512, E, nullptr, nullptr, nullptr, nullptr, v, v + 1, 0);
                        else rider_gemm<EpiWin, false, WMM>(R, (const bf16_t*)wa, D, (const bf16_t*)wb, DIN, D, EW, nullptr, nullptr, WSP(float, WS_SA), wsb, 1536 / 64 + v - 8, 1536 / 64 + v - 7, 0);
                    }
                } else {
                    const Frame L = local_frame(F); pg8::DenseOrder S; S.init(wa, wb, NTOK, DIN - WIN_NB, D, 1, L.nblk - nfirst, L.blk - nfirst, WIN_NB / 256); S.SB = wsb;
                    pg8::gemm_phase<EpiWin, pg8::DenseOrder, WMM>(L.lds, D, D, D, S, EW, L.tid, WSP(float, WS_SA));
                }
            }
            SEAM(sb + 3);
        }
        for (int rp = 0; rp <= REPS(5); ++rp) if (PHSEL(5) && IN(sb + 4)) { const Frame F = local_frame(F0);
            proj_gemm(F, WSP(bf16_t, T_SOLO), WSP(bf16_t, WS_WPROJ + layer * SZ_WPROJ), WSP(bf16_t, T_GATES), WSP(bf16_t, T_Y), (layer >= WOUT_F8_FROM) ? 1 : 0, !(SKIP_DEAD_META && layer == DEPTH - 1));
            SEAM(sb + 4);
        }
        for (int rp = 0; rp <= REPS(6); ++rp) if (PHSEL(6) && IN(sb + 5)) { const Frame F = local_frame(F0);
            EpiRes E{WSP(float, WS_HS), WSP(bf16_t, WS_HSB), WSP(float, WS_RSP), (rp < REPS(6)) ? 1 : 0, (moe || UMM != 1) ? nullptr : WSP(unsigned char, WS_HSB8), (layer >= WOUT_F8_FROM) ? FSC * (1.0f / YSC) : 1.0f, (SKIP_HS0 && layer == 0) ? F.in[0] : WSP(float, WS_HS)};
            EpiRes ER = E; if (SKIP_HS0 && layer == 0) ER.res = F.in[1] - (size_t)NTOK * D;
            unsigned* pc = (unsigned*)(GAS unsigned*)(F.ws + WS_PCNT) + (size_t)(layer * 2 + 0) * 65 * 16;
            if (FUSE_POST && UMM == 3) { if (moe) res_gemm<2, 2>(F, WSP(bf16_t, T_Y), WSP(bf16_t, WS_WOUT + layer * SZ_WPROJ), D, E, layer, pc); else res_gemm<2, 1>(F, WSP(bf16_t, T_Y), WSP(bf16_t, WS_WOUT + layer * SZ_WPROJ), D, E, layer, pc); }
            else if (WOUT_F8_FROM > 0 && layer < WOUT_F8_FROM) dense_gemm(F, WSP(bf16_t, T_Y), WSP(bf16_t, WS_WOUT + layer * SZ_WPROJ), D, D, E);
            else dense_gemm<EpiRes, 1>(F, WSP(unsigned char, T_Y), WSP(unsigned char, WS_WOUT + layer * SZ_WPROJ), D, D, E, nullptr, nullptr, &ER, -1, (SKIP_DEAD_META && layer == DEPTH - 1) ? 0 : -1);
            SEAM(sb + 5);
        }
        if (!moe) {
            if (UMM == 3 && !FUSE_POST) { for (int rp = 0; rp <= REPS(14); ++rp) { const Frame F = local_frame(F0); qnorm_rows(F); GRID_SYNC(); } }
            for (int rp = 0; rp <= REPS(7); ++rp) if (PHSEL(7) && IN(sb + 6)) { const Frame F = local_frame(F0);
                EpiUp E{WSP(float, WS_RSP), WSP(unsigned char, F_ACT), (rp < REPS(7)) ? 1 : 0, ((j == 0 ? DESZ_D : DESZ_D2) == 1) ? 1 : 0};
                dense_gemm<EpiUp, UMM>(F, UESZ == 1 ? WSP(unsigned char, WS_HSB8) : WSP(unsigned char, WS_HSB), WSP(unsigned char, WS_DGU + j * SZ_DGU), 2 * DFF, D, E, WSP(float, WS_SA), WSP(float, WS_CMAX) + j * 2 * DFF);
                SEAM(sb + 6);
            }
            for (int rp = 0; rp <= REPS(8); ++rp) if (PHSEL(8) && IN(sb + 7)) { const Frame F = local_frame(F0);

                EpiRes E{WSP(float, WS_HS), WSP(bf16_t, WS_HSB), WSP(float, WS_RSP), (rp < REPS(8)) ? 1 : 0, nullptr, ((j == 0 ? DESZ_D : DESZ_D2) == 1) ? FSC : 1.0f, WSP(float, WS_HS)};
                unsigned* pc = (unsigned*)(GAS unsigned*)(F.ws + WS_PCNT) + (size_t)(layer * 2 + 1) * 65 * 16;
                if (FUSE_POST && WMM == 3 && layer + 1 < DEPTH) res_gemm<DESZ_D, 1>(F, WSP(unsigned char, F_ACT), WSP(unsigned char, WS_DDN + j * SZ_DDN), DFF, E, layer, pc);
                else if (j == 0) dense_gemm<EpiRes, DESZ_D>(F, WSP(unsigned char, F_ACT), WSP(unsigned char, WS_DDN + j * SZ_DDN), D, DFF, E);
                else dense_gemm<EpiRes, DESZ_D2>(F, WSP(unsigned char, F_ACT), WSP(unsigned char, WS_DDN + j * SZ_DDN), D, DFF, E);
                if (layer + 1 < DEPTH) SEAM(sb + 7);
            }
            if (WMM == 3 && !FUSE_POST && layer + 1 < DEPTH) { const Frame F = local_frame(F0); qnorm_rows(F); GRID_SYNC(); }
        } else {
            if (FUSE_RD && UMM == 3 && (int)gridDim.x >= NCHUNK - 1) {
                if (PHSEL(9) && IN(sb + 6)) { const Frame F = local_frame(F0); moe_route_dispatch(F, layer); SEAM(sb + 7); }
            } else {
            for (int rp = 0; rp <= REPS(9); ++rp) if (PHSEL(9) && IN(sb + 6) && !(FUSE_POST && UMM == 3)) { const Frame F = local_frame(F0); moe_router(F, layer, -1, NCHUNK); SEAM(sb + 6); }
            for (int rp = 0; rp <= REPS(10); ++rp) if (PHSEL(10) && IN(sb + 7)) { const Frame F = local_frame(F0); moe_dispatch(F); SEAM(sb + 7); }
            }
            for (int rp = 0; rp <= REPS(11); ++rp) if (PHSEL(11) && IN(sb + 8)) { const Frame F = local_frame(F0);
                const int nslot = __builtin_amdgcn_readfirstlane(WSP(int, WS_TEXP)[200]) * 256;
                EpiMoeUp E{WSP(unsigned char, F_ACT)};
                const Frame L = local_frame(F);
                pg8::GroupedOrder S{(const char*)WSP(bf16_t, F_XS), (const char*)WSP(bf16_t, WS_MGU + (size_t)j * NEXP * SZ_MGU), WSP(int, WS_TEXP), nullptr, SZ_MGU, (size_t)256 * D * UESZ, (size_t)256 * D * UESZ,
                                    nslot >> 8, (2 * EFF) / 256, (nslot >> 8) * ((2 * EFF) / 256), L.nblk, L.blk, WSP(float, WS_CMAX) + CMAX_MOE + j * NEXP * 2 * EFF, 2 * EFF};
                pg8::gemm_phase<EpiMoeUp, pg8::GroupedOrder, UMM>(L.lds, D, D, D, S, E, L.tid, WSP(float, WS_SA));
                SEAM(sb + 8);
            }
            for (int rp = 0; rp <= REPS(12); ++rp) if (PHSEL(12) && IN(sb + 9)) { const Frame F = local_frame(F0);
                const int nslot = __builtin_amdgcn_readfirstlane(WSP(int, WS_TEXP)[200]) * 256;
                EpiMoeDown E{WSP(float, WS_SGATE), WSP(bf16_t, F_YS)};
                const Frame L = local_frame(F);
                pg8::GroupedOrder S{(const char*)WSP(bf16_t, F_ACT), (const char*)WSP(bf16_t, WS_MDN + (size_t)j * NEXP * SZ_MDN), WSP(int, WS_TEXP), nullptr, SZ_MDN, (size_t)256 * EFF * DESZ_M, (size_t)256 * EFF * DESZ_M,
                                    nslot >> 8, D / 256, (nslot >> 8) * (D / 256), L.nblk, L.blk, nullptr, 0};
                pg8::gemm_phase<EpiMoeDown, pg8::GroupedOrder, DESZ_M>(L.lds, EFF, EFF, EFF, S, E, L.tid);
                SEAM(sb + 9);
            }
            for (int rp = 0; rp <= REPS(13); ++rp) if (PHSEL(13) && IN(sb + 10)) { const Frame F = local_frame(F0); moe_combine(F, layer, (rp < REPS(13)) ? 1 : 0); if (layer + 1 < DEPTH) SEAM(sb + 10); }
        }
    }
}

static bool step_exists(int s) {
    if (s == 0) return true;
    const int layer = (s - 1) / STEPS_PER_LAYER, ls = (s - 1) % STEPS_PER_LAYER;
    if (layer & 1) return ls <= 10;
    return ls <= 7;
}
extern "C" void kernel_launch(void* const* d_in, const int* in_sizes, int n_in, void* d_out, int out_size, void* d_ws, size_t ws_size, hipStream_t stream) {
    static int grid = 0;
    if (grid == 0) {
        if (n_in != 35 || out_size != NTOK * D || ws_size < WS_END) { fprintf(stderr, "kernel_launch: unexpected problem (n_in %d out %d ws %zu need %zu)\n", n_in, out_size, ws_size, (size_t)WS_END); grid = -1; return; }
        int dev = 0, cus = 0;
        if (hipGetDevice(&dev) != hipSuccess || hipDeviceGetAttribute(&cus, hipDeviceAttributeMultiprocessorCount, dev) != hipSuccess) { grid = -1; return; }
        if (hipFuncSetAttribute((const void*)fwd, hipFuncAttributeMaxDynamicSharedMemorySize, LDS_BYTES) != hipSuccess) { fprintf(stderr, "kernel_launch: hipFuncSetAttribute failed\n"); grid = -1; return; }
        int per_cu = 0;
        if (hipOccupancyMaxActiveBlocksPerMultiprocessor(&per_cu, (const void*)fwd, NTHREADS, LDS_BYTES) != hipSuccess || per_cu < 1) { fprintf(stderr, "kernel_launch: occupancy query says %d\n", per_cu); }
        (void)hipGetLastError();
        grid = cus;
    }
    if (grid < 0) return;
    (void)hipMemsetAsync((char*)d_ws + WS_CTL, 0, CTL_BYTES, stream);
    Params p;
    memset(&p, 0, sizeof(p));
    for (int i = 0; i < 35; ++i) p.in[i] = (const float*)d_in[i];
    p.out = (float*)d_out; p.ws = (unsigned char*)d_ws;
#if ONE_LAUNCH
    p.s_lo = 0; p.s_hi = NSTEPS;
    hipLaunchKernelGGL(fwd, dim3(grid), dim3(NTHREADS), LDS_BYTES, stream, p);
#else
    for (int s = 0; s < NSTEPS; ++s) {
        if (!step_exists(s)) continue;
        p.s_lo = s; p.s_hi = s + 1;
        hipLaunchKernelGGL(fwd, dim3(grid), dim3(NTHREADS), LDS_BYTES, stream, p);
    }
#endif
}
```
